# Optimizing an MI355X kernel written in HIP

```python
import math
import jax, jax.numpy as jnp
from jax import lax
import numpy as np

D_MODEL = 4096
BATCH = 4
SEQ = 2048
DEPTH = 4
DEC_BATCH = 8
DEC_SEQ = 1
PAST_LEN = 8192
PAGE_SIZE = 128

N_A_LAYERS = DEPTH // 2
N_B_LAYERS = DEPTH - N_A_LAYERS
D_RNN = D_MODEL
LRU_BLOCKS = 16
LRU_BS = D_RNN // LRU_BLOCKS
CONV_W = 4
LRU_C = 8.0
N_HEADS = 32
HEAD_DIM = D_MODEL // N_HEADS
N_KV = 4
Q_PER_KV = N_HEADS // N_KV
CMP_BLK = 32
CMP_STRIDE = 16
CMP_HID = 2 * HEAD_DIM
SLC_BLK = 64
TOP_N = 16
WINDOW = 512
N_BUCKETS = 32
MAX_DIST = 128
GLOBAL_QBLK = 32
WIN_QBLK = 128
NEG = -1e30
BIG = 1e30
EPS = 1e-6

kernel_name = "yoco_rglru_nsa_decoder_step"


def rms_norm(x, g):
    xf = x.astype(jnp.float32)
    y = xf * lax.rsqrt(jnp.mean(xf * xf, axis=-1, keepdims=True) + EPS)
    return (y * g.astype(jnp.float32)).astype(x.dtype)


def rel_bucket(d):
    d = jnp.maximum(d, 0)
    n_exact = N_BUCKETS // 2
    df = jnp.maximum(d, 1).astype(jnp.float32)
    large = n_exact + (jnp.log(df / n_exact) / math.log(MAX_DIST / n_exact)
                       * (N_BUCKETS - n_exact)).astype(jnp.int32)
    large = jnp.minimum(large, N_BUCKETS - 1)
    return jnp.where(d < n_exact, d, large)


def rglru_layer(x, pos, h0, conv0, norm_g, w_in, conv_w, conv_b, w_rg, b_rg, w_ig, b_ig, lam, w_out):
    B, T, _ = x.shape
    u = rms_norm(x, norm_g) @ w_in
    xb, gate = u[..., :D_RNN], u[..., D_RNN:]
    xpad = jnp.concatenate([conv0.astype(xb.dtype), xb], axis=1)
    xc = conv_b
    for k in range(CONV_W):
        xc = xc + conv_w[k] * xpad[:, k:k + T]
    xblk = xc.reshape(B, T, LRU_BLOCKS, LRU_BS)
    r = jax.nn.sigmoid((jnp.einsum('btnd,nde->btne', xblk, w_rg).reshape(B, T, D_RNN) + b_rg).astype(jnp.float32))
    i = jax.nn.sigmoid((jnp.einsum('btnd,nde->btne', xblk, w_ig).reshape(B, T, D_RNN) + b_ig).astype(jnp.float32))
    log_a = -LRU_C * r * jax.nn.softplus(-lam.astype(jnp.float32))
    a = jnp.exp(log_a)
    mult = jnp.where((pos == 0)[None, :, None], 1.0, jnp.sqrt(-jnp.expm1(2.0 * log_a)))
    b_in = mult * i * xc.astype(jnp.float32)

    def step(h, ab):
        h = ab[0] * h + ab[1]
        return h, h

    h_last, hs = lax.scan(step, h0.astype(jnp.float32), (a.transpose(1, 0, 2), b_in.transpose(1, 0, 2)))
    hs = hs.transpose(1, 0, 2).astype(x.dtype)
    y = (hs * jax.nn.silu(gate)) @ w_out
    return x + y, h_last.astype(h0.dtype), xpad[:, T:].astype(conv0.dtype)


def shared_kv_rows(x, kv_norm, w_kv):
    B, T, _ = x.shape
    kv = (rms_norm(x, kv_norm) @ w_kv).reshape(B, T, 3, 2, N_KV, HEAD_DIM)
    return kv[:, :, 0], kv[:, :, 1], kv[:, :, 2]


def global_context(cmp_rows, slc_rows, k_norm, cmp_pos, w_cmp1, w_cmp2):
    L = cmp_rows.shape[1]
    n_cmp = (L - CMP_BLK) // CMP_STRIDE + 1
    n_slc = -(-L // SLC_BLK)
    idx = jnp.arange(n_cmp)[:, None] * CMP_STRIDE + jnp.arange(CMP_BLK)[None, :]
    blk = cmp_rows[:, idx] + cmp_pos.transpose(1, 0, 2)[None, None, :, :, None, :]
    hid = jax.nn.silu(jnp.einsum('bnlsgd,sldh->bsgnh', blk, w_cmp1))
    comp = jnp.einsum('bsgnh,shd->bsgnd', hid, w_cmp2)
    kc = rms_norm(comp[:, 0], k_norm[0])
    vc = comp[:, 1]

    def to_blocks(v):
        B = v.shape[0]
        v = jnp.pad(v, ((0, 0), (0, n_slc * SLC_BLK - L), (0, 0), (0, 0)))
        return v.reshape(B, n_slc, SLC_BLK, N_KV, HEAD_DIM).transpose(0, 3, 1, 2, 4)

    ks = to_blocks(rms_norm(slc_rows[:, :, 0], k_norm[1]))
    vs = to_blocks(slc_rows[:, :, 1])
    cs = jnp.arange(n_cmp)[:, None] * CMP_STRIDE
    ss = jnp.arange(n_slc)[None, :] * SLC_BLK
    ov = jnp.minimum(cs + CMP_BLK, ss + SLC_BLK) - jnp.maximum(cs, ss)
    m_imp = jnp.maximum(ov, 0).astype(jnp.float32) / CMP_BLK
    return kc, vc, ks, vs, m_imp


def nsa_global(q, q_pos, kc, vc, ks, vs, tbl, m_imp):
    B, G = q.shape[:2]
    n_cmp = kc.shape[2]
    n_slc = ks.shape[2]
    n_sel = min(TOP_N, n_slc)
    d_c = q_pos[:, None] - (jnp.arange(n_cmp) * CMP_STRIDE + (CMP_BLK - 1))[None, :]
    c_ok = d_c >= 0
    bias_c = tbl[:, rel_bucket(d_c)].transpose(0, 3, 1, 2)
    lc = jnp.einsum('bgrqd,bgnd->bgrqn', q, kc).astype(jnp.float32) + bias_c
    pc = jax.nn.softmax(jnp.where(c_ok, lc, NEG), axis=-1) * c_ok
    o_cmp = jnp.einsum('bgrqn,bgnd->bgrqd', pc.astype(vc.dtype), vc)
    imp = jnp.einsum('bgrqn,nj->bgqj', pc, m_imp)
    cur = q_pos // SLC_BLK
    j = jnp.arange(n_slc)[None, :]
    forced = (j == 0) | (j == cur[:, None]) | (j == cur[:, None] - 1)
    allowed = j <= cur[:, None]
    score = jnp.where(forced, BIG, jnp.where(allowed, imp, NEG))
    top_val, top_idx = lax.top_k(score, n_sel)
    blk_ok = top_val > 0.5 * NEG
    bi = jnp.arange(B)[:, None, None, None]
    gi = jnp.arange(G)[None, :, None, None]
    ksel = ks[bi, gi, top_idx]
    vsel = vs[bi, gi, top_idx]
    kpos = top_idx[..., None] * SLC_BLK + jnp.arange(SLC_BLK)
    d_s = q_pos[None, None, :, None, None] - kpos
    s_ok = blk_ok[..., None] & (d_s >= 0)
    bias_s = tbl[gi[..., None], rel_bucket(d_s)].transpose(0, 1, 5, 2, 3, 4)
    ls = jnp.einsum('bgrqd,bgqnkd->bgrqnk', q, ksel).astype(jnp.float32) + bias_s
    ls = jnp.where(s_ok[:, :, None], ls, NEG).reshape(B, G, q.shape[2], q.shape[3], n_sel * SLC_BLK)
    ps = jax.nn.softmax(ls, axis=-1).reshape(B, G, q.shape[2], q.shape[3], n_sel, SLC_BLK)
    o_slc = jnp.einsum('bgrqnk,bgqnkd->bgrqd', ps.astype(vsel.dtype), vsel)
    return o_cmp, o_slc


def window_attn(q, q_pos, kw, vw, k_pos, tbl):
    d = q_pos[:, None] - k_pos[None, :]
    ok = (d >= 0) & (d <= WINDOW) & (k_pos[None, :] >= 0)
    bias = tbl[:, rel_bucket(d)].transpose(0, 3, 1, 2)
    lw = jnp.einsum('bgrqd,bgkd->bgrqk', q, kw).astype(jnp.float32) + bias
    pw = jax.nn.softmax(jnp.where(ok, lw, NEG), axis=-1)
    return jnp.einsum('bgrqk,bgkd->bgrqd', pw.astype(vw.dtype), vw)


def prompt_attend(q, ctx, win_rows, k_norm, tbl):
    kc, vc, ks, vs, m_imp = ctx
    B, G, R, T, HD = q.shape
    pos = jnp.arange(T, dtype=jnp.int32)
    nq = T // GLOBAL_QBLK
    qg = q.reshape(B, G, R, nq, GLOBAL_QBLK, HD).transpose(3, 0, 1, 2, 4, 5)
    o_cmp, o_slc = lax.map(lambda a: nsa_global(a[0], a[1], kc, vc, ks, vs, tbl, m_imp),
                           (qg, pos.reshape(nq, GLOBAL_QBLK)))
    o_cmp = o_cmp.transpose(1, 2, 3, 0, 4, 5).reshape(B, G, R, T, HD)
    o_slc = o_slc.transpose(1, 2, 3, 0, 4, 5).reshape(B, G, R, T, HD)
    pad = ((0, 0), (0, 0), (WINDOW, 0), (0, 0))
    kw_pad = jnp.pad(rms_norm(win_rows[:, :, 0], k_norm[2]).transpose(0, 2, 1, 3), pad)
    vw_pad = jnp.pad(win_rows[:, :, 1].transpose(0, 2, 1, 3), pad)
    nw = T // WIN_QBLK
    qw = q.reshape(B, G, R, nw, WIN_QBLK, HD).transpose(3, 0, 1, 2, 4, 5)

    def win_block(a):
        qb, c = a
        start = c * WIN_QBLK
        kb = lax.dynamic_slice_in_dim(kw_pad, start, WINDOW + WIN_QBLK, axis=2)
        vb = lax.dynamic_slice_in_dim(vw_pad, start, WINDOW + WIN_QBLK, axis=2)
        k_pos = start - WINDOW + jnp.arange(WINDOW + WIN_QBLK, dtype=jnp.int32)
        q_pos = start + jnp.arange(WIN_QBLK, dtype=jnp.int32)
        return window_attn(qb, q_pos, kb, vb, k_pos, tbl)

    o_win = lax.map(win_block, (qw, jnp.arange(nw, dtype=jnp.int32)))
    o_win = o_win.transpose(1, 2, 3, 0, 4, 5).reshape(B, G, R, T, HD)
    return o_cmp, o_slc, o_win


def sample_attend(q, q_pos, ctx, full_win, win_pos, k_norm, tbl):
    kc, vc, ks, vs, m_imp = ctx
    o_cmp, o_slc = nsa_global(q, q_pos, kc, vc, ks, vs, tbl, m_imp)
    kw = rms_norm(full_win[:, :, 0], k_norm[2]).transpose(0, 2, 1, 3)
    vw = full_win[:, :, 1].transpose(0, 2, 1, 3)
    o_win = window_attn(q, q_pos, kw, vw, win_pos, tbl)
    return o_cmp, o_slc, o_win


def nsa_layer(x, attend, norm_g, w_in, gate_bias, q_norm, w_out):
    B, T, _ = x.shape
    HQ = N_HEADS * HEAD_DIM
    u = rms_norm(x, norm_g) @ w_in
    q = rms_norm(u[..., :HQ].reshape(B, T, N_KV, Q_PER_KV, HEAD_DIM), q_norm) * HEAD_DIM ** -0.5
    q = q.transpose(0, 2, 3, 1, 4)
    gate = u[..., HQ:2 * HQ]
    bg = jax.nn.sigmoid((u[..., 2 * HQ:] + gate_bias).astype(jnp.float32))
    bg = bg.reshape(B, T, N_KV, Q_PER_KV, 3).transpose(0, 2, 3, 1, 4)
    o_cmp, o_slc, o_win = attend(q)
    o = bg[..., 0:1] * o_cmp + bg[..., 1:2] * o_slc + bg[..., 2:3] * o_win
    o = o.transpose(0, 3, 1, 2, 4).reshape(B, T, HQ).astype(x.dtype)
    return x + (o * jax.nn.silu(gate)) @ w_out


def setup_inputs(seed: int = 0) -> dict:
    key = jax.random.key(seed)
    ks = jax.random.split(key, 32)
    f = jnp.float32
    n_pages = PAST_LEN // PAGE_SIZE
    n_used = DEC_BATCH * n_pages
    n_pool = (5 * n_used + 3) // 4
    wb = min(WINDOW, PAST_LEN)
    A, Bn = N_A_LAYERS, N_B_LAYERS

    def nrm(k, shape, scale):
        return jax.random.normal(k, shape, f) * scale

    a0 = jax.random.uniform(ks[16], (A, D_RNN), f, 0.9, 0.999)
    s = a0 ** (1.0 / LRU_C)
    return {
        "x_prompt": nrm(ks[0], (BATCH, SEQ, D_MODEL), 1.0),
        "x_sample": nrm(ks[1], (DEC_BATCH, DEC_SEQ, D_MODEL), 1.0),
        "cache_cmp_kv": nrm(ks[2], (n_pool, PAGE_SIZE, 2, N_KV, HEAD_DIM), 1.0),
        "cache_slc_kv": nrm(ks[3], (n_pool, PAGE_SIZE, 2, N_KV, HEAD_DIM), 1.0),
        "state_win_kv": nrm(ks[4], (DEC_BATCH, wb, 2, N_KV, HEAD_DIM), 1.0),
        "state_lru_h": nrm(ks[5], (A, DEC_BATCH, D_RNN), 0.5),
        "state_conv": nrm(ks[6], (A, DEC_BATCH, CONV_W - 1, D_RNN), 1.0),
        "page_table": jax.random.permutation(ks[7], n_pool)[:n_used].reshape(DEC_BATCH, n_pages).astype(jnp.int32),
        "a_norm": 1.0 + nrm(ks[8], (A, D_MODEL), 0.02),
        "a_w_in": nrm(ks[9], (A, D_MODEL, 2 * D_RNN), D_MODEL ** -0.5),
        "a_conv_w": nrm(ks[10], (A, CONV_W, D_RNN), CONV_W ** -0.5),
        "a_conv_b": nrm(ks[11], (A, D_RNN), 0.02),
        "a_w_rg": nrm(ks[12], (A, LRU_BLOCKS, LRU_BS, LRU_BS), LRU_BS ** -0.5),
        "a_b_rg": nrm(ks[13], (A, D_RNN), 0.02),
        "a_w_ig": nrm(ks[14], (A, LRU_BLOCKS, LRU_BS, LRU_BS), LRU_BS ** -0.5),
        "a_b_ig": nrm(ks[15], (A, D_RNN), 0.02),
        "a_lambda": jnp.log(s) - jnp.log1p(-s),
        "a_w_out": nrm(ks[17], (A, D_RNN, D_MODEL), D_RNN ** -0.5),
        "kv_norm": 1.0 + nrm(ks[18], (D_MODEL,), 0.02),
        "w_kv": nrm(ks[19], (D_MODEL, 6 * N_KV * HEAD_DIM), D_MODEL ** -0.5),
        "k_norm": 1.0 + nrm(ks[20], (3, HEAD_DIM), 0.02),
        "cmp_pos": nrm(ks[21], (2, CMP_BLK, HEAD_DIM), 0.1),
        "w_cmp1": nrm(ks[22], (2, CMP_BLK, HEAD_DIM, CMP_HID), (CMP_BLK * HEAD_DIM) ** -0.5),
        "w_cmp2": nrm(ks[23], (2, CMP_HID, HEAD_DIM), CMP_HID ** -0.5),
        "rel_table": nrm(ks[24], (N_BUCKETS, N_HEADS), 0.5),
        "b_norm": 1.0 + nrm(ks[25], (Bn, D_MODEL), 0.02),
        "b_w_in": nrm(ks[26], (Bn, D_MODEL, 2 * N_HEADS * HEAD_DIM + 3 * N_HEADS), D_MODEL ** -0.5),
        "b_gate_bias": nrm(ks[27], (Bn, 3 * N_HEADS), 0.1),
        "b_q_norm": 1.0 + nrm(ks[28], (Bn, HEAD_DIM), 0.02),
        "b_w_out": nrm(ks[29], (Bn, N_HEADS * HEAD_DIM, D_MODEL), (N_HEADS * HEAD_DIM) ** -0.5),
    }


def reference(x_prompt, x_sample, cache_cmp_kv, cache_slc_kv, state_win_kv, state_lru_h,
              state_conv, page_table, a_norm, a_w_in, a_conv_w, a_conv_b, a_w_rg, a_b_rg,
              a_w_ig, a_b_ig, a_lambda, a_w_out, kv_norm, w_kv, k_norm, cmp_pos, w_cmp1,
              w_cmp2, rel_table, b_norm, b_w_in, b_gate_bias, b_q_norm, b_w_out):
    tbl = rel_table.astype(jnp.float32).reshape(N_BUCKETS, N_KV, Q_PER_KV).transpose(1, 0, 2)
    n_pages = PAST_LEN // PAGE_SIZE
    wb = min(WINDOW, PAST_LEN)
    pos_p = jnp.arange(SEQ, dtype=jnp.int32)
    pos_s = PAST_LEN + jnp.arange(DEC_SEQ, dtype=jnp.int32)
    xp, xs = x_prompt, x_sample
    h0_p = jnp.zeros((BATCH, D_RNN), x_prompt.dtype)
    conv0_p = jnp.zeros((BATCH, CONV_W - 1, D_RNN), x_prompt.dtype)
    p_h, p_c, s_h, s_c = [], [], [], []
    for layer in range(DEPTH):
        if layer < N_A_LAYERS:
            wa = (a_norm[layer], a_w_in[layer], a_conv_w[layer], a_conv_b[layer], a_w_rg[layer],
                  a_b_rg[layer], a_w_ig[layer], a_b_ig[layer], a_lambda[layer], a_w_out[layer])
            xp, hp, cp = rglru_layer(xp, pos_p, h0_p, conv0_p, *wa)
            xs, hs, cs = rglru_layer(xs, pos_s, state_lru_h[layer], state_conv[layer], *wa)
            p_h.append(hp)
            p_c.append(cp)
            s_h.append(hs)
            s_c.append(cs)
            continue
        if layer == N_A_LAYERS:
            p_cmp_kv, p_slc_kv, p_win_rows = shared_kv_rows(xp, kv_norm, w_kv)
            s_cmp_kv, s_slc_kv, s_win_rows = shared_kv_rows(xs, kv_norm, w_kv)
            ctx_p = global_context(p_cmp_kv, p_slc_kv, k_norm, cmp_pos, w_cmp1, w_cmp2)
            past_cmp = cache_cmp_kv[page_table].reshape(DEC_BATCH, n_pages * PAGE_SIZE, 2, N_KV, HEAD_DIM)
            past_slc = cache_slc_kv[page_table].reshape(DEC_BATCH, n_pages * PAGE_SIZE, 2, N_KV, HEAD_DIM)
            ctx_s = global_context(jnp.concatenate([past_cmp, s_cmp_kv], axis=1),
                                   jnp.concatenate([past_slc, s_slc_kv], axis=1),
                                   k_norm, cmp_pos, w_cmp1, w_cmp2)
            full_win = jnp.concatenate([state_win_kv, s_win_rows], axis=1)
            win_pos = PAST_LEN - wb + jnp.arange(wb + DEC_SEQ, dtype=jnp.int32)
            attend_p = lambda q: prompt_attend(q, ctx_p, p_win_rows, k_norm, tbl)
            attend_s = lambda q: sample_attend(q, pos_s, ctx_s, full_win, win_pos, k_norm, tbl)
        li = layer - N_A_LAYERS
        wb_l = (b_norm[li], b_w_in[li], b_gate_bias[li], b_q_norm[li], b_w_out[li])
        xp = nsa_layer(xp, attend_p, *wb_l)
        xs = nsa_layer(xs, attend_s, *wb_l)
    p_win_kv = p_win_rows[:, SEQ - min(WINDOW, SEQ):]
    s_win_kv = full_win[:, full_win.shape[1] - min(WINDOW, PAST_LEN + DEC_SEQ):]
    p_lru_h = jnp.stack(p_h)
    p_conv = jnp.stack(p_c)
    s_lru_h = jnp.stack(s_h)
    s_conv = jnp.stack(s_c)
    return (xp, xs, p_cmp_kv, p_slc_kv, p_win_kv, p_lru_h, p_conv,
            s_cmp_kv, s_slc_kv, s_win_kv, s_lru_h, s_conv)
```

```cpp
#include <hip/hip_runtime.h>
#include <cstdio>
#include <cstdint>

#define LAS __attribute__((address_space(3)))
#define GAS __attribute__((address_space(1)))
typedef unsigned short bf16_t;
typedef short bf16x8 __attribute__((ext_vector_type(8)));
typedef short s16x4 __attribute__((ext_vector_type(4)));
typedef float f32x4 __attribute__((ext_vector_type(4)));
typedef float f32x2 __attribute__((ext_vector_type(2)));
typedef float f32x16 __attribute__((ext_vector_type(16)));
typedef unsigned u32x4 __attribute__((ext_vector_type(4)));
typedef unsigned u32x2 __attribute__((ext_vector_type(2)));
#define DI __device__ __forceinline__

constexpr int DM = 4096, SEQ = 2048, NBATCH = 4, MP = NBATCH * SEQ  , NSMP = 8, PAST = 8192;
constexpr int NHEAD = 32, HD = 128, NKV = 4, RPG = 8, NIN = 8288  , NINP = 8448;
constexpr float EPS = 1e-6f, LOG2E = 1.4426950408889634f;
constexpr int NPHASE = 25;

constexpr size_t O_YP = 0, O_YS = O_YP + (size_t)MP * DM, O_PCMP = O_YS + (size_t)NSMP * DM, O_PSLC = O_PCMP + (size_t)MP * 1024,
    O_PWIN = O_PSLC + (size_t)MP * 1024, O_PLRU = O_PWIN + (size_t)NBATCH * 512 * 1024, O_PCONV = O_PLRU + 2 * NBATCH * DM,
    O_SCMP = O_PCONV + 2 * NBATCH * 3 * DM, O_SSLC = O_SCMP + NSMP * 1024, O_SWIN = O_SSLC + NSMP * 1024,
    O_SLRU = O_SWIN + (size_t)NSMP * 512 * 1024, O_SCONV = O_SLRU + 2 * NSMP * DM, O_END = O_SCONV + 2 * NSMP * 3 * DM;

constexpr size_t MiB = 1u << 20;
constexpr size_t WS_CTL = 0, CTL_BYTES = 1 * MiB;
constexpr size_t WS_W1T = 1 * MiB;
constexpr size_t WS_WGT = WS_W1T + 2 * 64 * MiB;
constexpr size_t WS_W2T = WS_WGT + 2 * 4 * MiB;
constexpr size_t WS_WKVT = WS_W2T + 2 * 32 * MiB;
constexpr size_t WS_WINT = WS_WKVT + 24 * MiB;
constexpr size_t WS_WOUTT = WS_WINT + 2 * 66 * MiB;
constexpr size_t WS_WC1T = WS_WOUTT + 2 * 32 * MiB;
constexpr size_t WS_WC2T = WS_WC1T + 4 * MiB;
constexpr size_t WS_SMALL = WS_WC2T + 1 * MiB;
constexpr size_t WS_CMPS = WS_SMALL + 2 * MiB;
constexpr size_t WS_XB16 = WS_CMPS + 129 * MiB;
constexpr size_t WS_U = WS_XB16 + 65 * MiB;
constexpr size_t WS_XC = WS_U + 128 * MiB;
constexpr size_t WS_LA = WS_XC + 64 * MiB;
constexpr size_t WS_BIN = WS_LA + 64 * MiB;
constexpr size_t WS_HG = WS_BIN + 64 * MiB;
constexpr size_t WS_XA = WS_HG + 64 * MiB;
constexpr size_t WS_XBF = WS_XA + 128 * MiB;
constexpr size_t WS_WINRAW = WS_XBF + 128 * MiB;
constexpr size_t WS_SLCK = WS_WINRAW + 32 * MiB;
constexpr size_t WS_SLCV = WS_SLCK + 8 * MiB, WS_WINK = WS_SLCV + 8 * MiB, WS_WINV = WS_WINK + 8 * MiB;
constexpr size_t WS_CMPP = WS_WINV + 8 * MiB;
constexpr size_t WS_HIDS = WS_CMPP + 17 * MiB;
constexpr size_t WS_KCS = WS_HIDS + 16 * MiB, WS_VCS = WS_KCS + 4 * MiB;
constexpr size_t WS_KCP = WS_VCS + 4 * MiB, WS_VCP = WS_KCP + 1 * MiB;
constexpr size_t WS_AGG = WS_VCP + 1 * MiB;
constexpr size_t WS_XB16B = WS_AGG + 2 * MiB;
constexpr size_t WS_YB = WS_XB16B + 65 * MiB;
constexpr size_t WS_END = WS_YB + 64 * MiB;
constexpr int SM_RS = 0;
constexpr int SM_SP8 = 8448;
constexpr int SM_POSBP = SM_SP8 + 8192;
constexpr int SM_POSB = SM_POSBP + 8192;
constexpr int SM_LUT = SM_POSB + 512;
constexpr int SM_XS = SM_LUT + 32 * 132;
constexpr int SM_XS16 = SM_XS + 2 * 32768;
constexpr int SM_US = SM_XS16 + 16384;
constexpr int SM_XCS16 = SM_US + 8 * 8448;
constexpr int SM_XCS = SM_XCS16 + 16384;
constexpr int SM_GS = SM_XCS + 32768;
constexpr int SM_HGS16 = SM_GS + 65536;
constexpr int SM_KVS = SM_HGS16 + 16384;
constexpr int SM_AOS16 = SM_KVS + 8 * 3072;
constexpr int SM_XS16B = SM_AOS16 + 16384;
constexpr int SM_ONES = SM_XS16B + 16384;
constexpr int SM_END = SM_ONES + 8192;
static_assert((size_t)SM_END * 4 <= 2 * MiB, "small region");
constexpr int CW_BAR = 4096, CW_QUEUE = 8192, CW_SPLIT = 12288;

constexpr int LDS_MAIN = 147712;
constexpr int LDS_MISC = LDS_MAIN;
constexpr int LDS_WTAB = LDS_MAIN + 256;
constexpr int LDS_BYTES = LDS_MAIN + 512;

DI int hw_wave_key() { return (int)__builtin_amdgcn_s_getreg((5 << 11) | 4); }
DI int tid_now(LAS unsigned char* lds) { const int wv = __builtin_amdgcn_readfirstlane(((volatile LAS int*)(lds + LDS_WTAB))[hw_wave_key()]); int l;
    asm volatile("v_mbcnt_lo_u32_b32 %0, -1, 0\n\tv_mbcnt_hi_u32_b32 %0, -1, %0" : "=v"(l)); return wv * 64 + l; }
DI int tid_now_st(volatile LAS unsigned* st) { return tid_now((LAS unsigned char*)(st - 8) - LDS_MISC); }
DI float bf2f(unsigned v) { return __uint_as_float(v << 16); }
DI unsigned cvt_pk_bf16(float lo, float hi) { unsigned r; asm volatile("v_cvt_pk_bf16_f32 %0, %1, %2" : "=v"(r) : "v"(lo), "v"(hi)); return r; }
DI float lo_bf(unsigned w) { return __uint_as_float(w << 16); }
DI float hi_bf(unsigned w) { return __uint_as_float(w & 0xffff0000u); }
DI float frcp(float x) { return __builtin_amdgcn_rcpf(x); }
DI float fsqrt(float x) { return __builtin_amdgcn_sqrtf(x); }
DI float frsq(float x) { return __builtin_amdgcn_rsqf(x); }
DI float fexp(float x) { return __builtin_amdgcn_exp2f(x * 1.4426950408889634f); }
DI float sigmoidf_(float x) { return frcp(1.f + __builtin_amdgcn_exp2f(x * -1.4426950408889634f)); }
DI float siluf_(float x) { return x * sigmoidf_(x); }
template <int O> DI float shx(float v) { static_assert(O >= 1 && O < 32, "ds_swizzle xor mask"); return __int_as_float(__builtin_amdgcn_ds_swizzle(__float_as_int(v), (O << 10) | 0x1f)); }
template <int O> DI unsigned shxu(unsigned v) { return (unsigned)__builtin_amdgcn_ds_swizzle((int)v, (O << 10) | 0x1f); }
DI float half_sum(float v) { auto rr = __builtin_amdgcn_permlane32_swap(__float_as_uint(v), __float_as_uint(v), false, false); return __uint_as_float(rr[0]) + __uint_as_float(rr[1]); }
DI float half_max(float v) { auto rr = __builtin_amdgcn_permlane32_swap(__float_as_uint(v), __float_as_uint(v), false, false); return fmaxf(__uint_as_float(rr[0]), __uint_as_float(rr[1])); }
DI float half_other(float v, int hi) { auto rr = __builtin_amdgcn_permlane32_swap(__float_as_uint(v), __float_as_uint(v), false, false); return __uint_as_float(hi ? rr[0] : rr[1]); }
DI float sum32(float v) { v += shx<1>(v); v += shx<2>(v); v += shx<4>(v); v += shx<8>(v); v += shx<16>(v); return v; }
DI float sum16(float v) { v += shx<1>(v); v += shx<2>(v); v += shx<4>(v); v += shx<8>(v); return v; }
DI float max32(float v) { v = fmaxf(v, shx<1>(v)); v = fmaxf(v, shx<2>(v)); v = fmaxf(v, shx<4>(v)); v = fmaxf(v, shx<8>(v)); v = fmaxf(v, shx<16>(v)); return v; }
DI float wave_sum(float v) { return half_sum(sum32(v)); }
DI float wave_max(float v) { return half_max(max32(v)); }
DI u32x4 pack8f(const float* v) { u32x4 w; w.x = cvt_pk_bf16(v[0], v[1]); w.y = cvt_pk_bf16(v[2], v[3]); w.z = cvt_pk_bf16(v[4], v[5]); w.w = cvt_pk_bf16(v[6], v[7]); return w; }
DI void unpack8(u32x4 w, float* v) { v[0] = lo_bf(w.x); v[1] = hi_bf(w.x); v[2] = lo_bf(w.y); v[3] = hi_bf(w.y); v[4] = lo_bf(w.z); v[5] = hi_bf(w.z); v[6] = lo_bf(w.w); v[7] = hi_bf(w.w); }

#define XB_TMO      128
#define XB_XCNT(j)  (256  + 64 * (j))
#define XB_XSUB(j)  (1280 + 64 * (j))
#define XB_XGEN(j)  (2304 + 64 * (j))
#define XB_TOP      3328
#define XB_TOPGEN   3392
#define XCD_BAR_WORDS 3456
#define XB_SPIN_CAP (1u << 18)
__device__ __forceinline__ unsigned xb_ld(unsigned* p)              { return __hip_atomic_load(p, __ATOMIC_RELAXED, __HIP_MEMORY_SCOPE_AGENT); }
__device__ __forceinline__ unsigned xb_add(unsigned* p, unsigned v) { return __hip_atomic_fetch_add(p, v, __ATOMIC_RELAXED, __HIP_MEMORY_SCOPE_AGENT); }
__device__ __forceinline__ unsigned xb_xcc_id() { return (unsigned)__builtin_amdgcn_s_getreg((3 << 11) | 20) & 0xFu; }
#define XB_SPIN(cond, bar) do { unsigned _sp = 0; while (cond) { __builtin_amdgcn_s_sleep(1); \
    if ((++_sp & 255u) == 0u) { if (xb_ld(&(bar)[XB_TMO])) break; if (_sp > XB_SPIN_CAP) { atomicAdd(&(bar)[XB_TMO], 1u); break; } } } } while (0)
struct XcdBarrier { unsigned* bar; unsigned x; volatile LAS unsigned* st; };
__device__ __forceinline__ XcdBarrier xcd_barrier_post(unsigned* bar, volatile LAS unsigned* st) {
    XcdBarrier b; b.bar = bar; b.x = xb_xcc_id(); b.st = st;
    if (tid_now_st(st) == 0) (void)xb_add(&bar[XB_XCNT(b.x)], 1u);
    return b;
}
__device__ __forceinline__ void xcd_barrier_complete(unsigned* bar, unsigned x, unsigned& nloc, unsigned& nx) {
    const unsigned G = gridDim.x * gridDim.y * gridDim.z;
    unsigned sum, cnt, mine, sp = 0u;
    for (;;) {
        sum = 0u; cnt = 0u; mine = 0u;
#pragma unroll 1
        for (unsigned j = 0; j < 16; ++j) { const unsigned c = xb_ld(&bar[XB_XCNT(j)]); sum += c; cnt += (c > 0u) ? 1u : 0u; mine = (j == x) ? c : mine; }
        if (sum == G) break;
        __builtin_amdgcn_s_sleep(1);
        if ((++sp & 255u) == 0u) { if (xb_ld(&bar[XB_TMO])) break; if (sp > XB_SPIN_CAP) { atomicAdd(&bar[XB_TMO], 1u); break; } }
    }
    nloc = mine > 0u ? mine : 1u; nx = cnt > 0u ? cnt : 1u;
}
__device__ __forceinline__ void xcd_barrier(const XcdBarrier& b) {
    asm volatile("s_waitcnt vmcnt(0)" ::: "memory");
    __syncthreads();
    if (tid_now_st(b.st) == 0) {
        unsigned* bar = b.bar;
        __builtin_amdgcn_s_waitcnt(0);
        unsigned nloc = b.st[0], nx = b.st[1];
        if (nloc == 0u) { xcd_barrier_complete(bar, b.x, nloc, nx); b.st[0] = nloc; b.st[1] = nx; }
        const unsigned old = xb_add(&bar[XB_XSUB(b.x)], 1u);
        const unsigned gen = old / nloc;
        if (old + 1u == (gen + 1u) * nloc) {
            __builtin_amdgcn_fence(__ATOMIC_RELEASE, "agent");
            asm volatile("s_waitcnt vmcnt(0)" ::: "memory");
            const unsigned og = xb_add(&bar[XB_TOP], 1u);
            const unsigned tg = og / nx;
            if (og + 1u == (tg + 1u) * nx) xb_add(&bar[XB_TOPGEN], 1u);
            else XB_SPIN(xb_ld(&bar[XB_TOPGEN]) == tg, bar);
            __builtin_amdgcn_fence(__ATOMIC_ACQUIRE, "agent");
            xb_add(&bar[XB_XGEN(b.x)], 1u);
            asm volatile("s_waitcnt vmcnt(0)" ::: "memory");
        } else {
            XB_SPIN(xb_ld(&bar[XB_XGEN(b.x)]) == gen, bar);
            __builtin_amdgcn_fence(__ATOMIC_ACQUIRE, "agent");
            asm volatile("s_waitcnt vmcnt(0)" ::: "memory");
        }
    }
    __syncthreads();
}

__device__ __forceinline__ void split_arrive(unsigned* ctr, volatile LAS unsigned* st) {
    asm volatile("s_waitcnt vmcnt(0)" ::: "memory");
    __syncthreads();
    if (tid_now_st(st) == 0) { __builtin_amdgcn_fence(__ATOMIC_RELEASE, "agent"); asm volatile("s_waitcnt vmcnt(0)" ::: "memory"); (void)xb_add(ctr, 1u); }
}
__device__ __forceinline__ void split_wait(unsigned* ctr, unsigned target, volatile LAS unsigned* st) {
    if (tid_now_st(st) == 0) { while (xb_ld(ctr) < target) __builtin_amdgcn_s_sleep(1); }
    __syncthreads();
    __builtin_amdgcn_fence(__ATOMIC_ACQUIRE, "agent");
}

namespace pg8 {
constexpr int BM = 256, BK = 64, HALF = 128, HTB = HALF * BK * 2, STAGE_BYTES = 8 * HTB, NXCD = 8, WGM = 8;
__host__ __device__ __forceinline__ int lds_byte(int r, int c) { const int st = (r >> 4) * 2 + (c >> 5), rr = r & 15, cc = c & 31, ob = rr * 64 + cc * 2; return st * 1024 + (ob ^ (((ob >> 9) & 1) << 5)); }
__host__ __device__ __forceinline__ void stage_rc(int b, int& R, int& C) { const int st = b / 1024, sb = b % 1024, swz = sb ^ (((sb >> 9) & 1) << 5); R = (st >> 1) * 16 + swz / 64; C = (st & 1) * 32 + (swz % 64) / 2; }
__host__ __device__ __forceinline__ int perm32(int rho) { const int n = rho >> 4, i = rho & 15; return 8 * (i >> 2) + 4 * n + (i & 3); }

struct Unit { int pm, pn, ks; };
struct Gemm { const bf16_t* A; const bf16_t* Bt; int lda, ldb, K, ablk;
    unsigned* wctr = nullptr; unsigned wtarget = 0; volatile LAS unsigned* wst = nullptr;
    DI const char* a_ptr(const Unit& u) const { return (const char*)(A + (size_t)u.pm * BM * lda + (size_t)u.ks * K + (ablk ? (u.pn >> 1) * 256 : 0)); }
    DI const char* b_ptr(const Unit& u) const { return (const char*)(Bt + (size_t)u.pn * BM * ldb + (size_t)u.ks * K); }
};
struct StaticOrder {
    int nM, nN, nwg, G, c;
    DI void init(int M, int N, int G_, int c_) { nM = M / BM; nN = N / BM; nwg = nM * nN; G = G_; c = c_; }
    DI bool next(int i, Unit& u) const {
        const long L = (long)i * G + c; if (L >= nwg) return false;
        int wgid = (int)L; { const int q = nwg / NXCD, r = nwg % NXCD, xcd = wgid % NXCD, off = wgid / NXCD; wgid = (xcd < r ? xcd * (q + 1) : r * (q + 1) + (xcd - r) * q) + off; }
        const int nig = WGM * nN, gid = wgid / nig, fm = gid * WGM, gsz = (nM - fm) < WGM ? (nM - fm) : WGM;
        u.pm = fm + ((wgid % nig) % gsz); u.pn = (wgid % nig) / gsz; u.ks = 0; return true;
    }
};
struct ListOrder {
    int total, G, c, kshift, kmask, mode;
    DI bool next(int i, Unit& u) const {
        const int L = i * G + c; if (c < 0 || L >= total) return false;
        u.pm = L >> kshift; u.ks = L & kmask; u.pn = mode == 0 ? (u.pm >> 6) : mode == 1 ? (u.pm >> 3) : 32; return true;
    }
};

template <class Epi, class Sched>
__device__ __forceinline__ void gemm_phase(LAS unsigned char* lds, const Gemm g, const Sched& S, const Epi& E) {
    int tid = tid_now(lds); asm volatile("" : "+v"(tid));
    const int wid = __builtin_amdgcn_readfirstlane(tid >> 6), lane = tid & 63, wr = wid >> 2, wc = wid & 3, fr = lane & 15, fq = lane >> 4;
    const int K = g.K, nt = K / BK;
    unsigned voffA, voffB;
    { int R, C; stage_rc(tid * 16, R, C); const int Rb = Epi::PERM ? ((R & ~31) + perm32(R & 31)) : R;
      voffA = (unsigned)(R * g.lda + C) * 2u; voffB = (unsigned)(Rb * g.ldb + C) * 2u; }
    const size_t rstep_voffA = (size_t)64 * g.lda * 2, rstep_voffB = (size_t)64 * g.ldb * 2;
    const size_t kstep = (size_t)(BK * 2);
    const size_t hstepA = (size_t)HALF * g.lda * 2, hstepB = (size_t)HALF * g.ldb * 2;
    const unsigned ldsw = (unsigned)wid * 1024u;
    const int aoff = lds_byte(wr * 64 + fr, fq * 8), boff = lds_byte(wc * 32 + fr, fq * 8);
#define PG8_SA(b, h) (((b) * 2 + (h)) * HTB)
#define PG8_SB(b, h) ((4 + (b) * 2 + (h)) * HTB)
#define PG8_STAGE(bufoff, gbase, voff) do { _Pragma("unroll") for (int _i = 0; _i < 2; ++_i) \
        __builtin_amdgcn_global_load_lds((const unsigned*)((const char*)(gbase) + (size_t)_i * rstep_##voff + (voff)), (LAS unsigned*)(lds + (bufoff) + ldsw + _i * 8192), 16, 0, 0); } while (0)
#define PG8_LDA(dst, b, h) do { _Pragma("unroll") for (int m = 0; m < 4; ++m) _Pragma("unroll") for (int k = 0; k < 2; ++k) dst[m][k] = *(const LAS bf16x8*)(lds + PG8_SA(b, h) + aoff + m * 2048 + k * 1024); } while (0)
#define PG8_LDB(dst, b, h) do { _Pragma("unroll") for (int n = 0; n < 2; ++n) _Pragma("unroll") for (int k = 0; k < 2; ++k) dst[n][k] = *(const LAS bf16x8*)(lds + PG8_SB(b, h) + boff + n * 2048 + k * 1024); } while (0)
#define PG8_MMA(ai, bj, At, Bt) do { __builtin_amdgcn_s_setprio(1); _Pragma("unroll") for (int m = 0; m < 4; ++m) _Pragma("unroll") for (int n = 0; n < 2; ++n) _Pragma("unroll") for (int k = 0; k < 2; ++k) \
        acc[ai][bj][m][n] = __builtin_amdgcn_mfma_f32_16x16x32_bf16(Bt[n][k], At[m][k], acc[ai][bj][m][n], 0, 0, 0); __builtin_amdgcn_s_setprio(0); } while (0)
#define PG8_WAIT_V(n) asm volatile("s_waitcnt vmcnt(" #n ")" ::: "memory")
#define PG8_WAIT_L(n) asm volatile("s_waitcnt lgkmcnt(" #n ")" ::: "memory")
#define PG8_BAR __builtin_amdgcn_s_barrier()
#define PG8_SCHED __builtin_amdgcn_sched_barrier(0)
    Unit cur, nxt; int ui = 0;
    if (!S.next(0, cur)) return;
    f32x4 acc[2][2][4][2];
#pragma unroll
    for (int a = 0; a < 2; ++a)
#pragma unroll
        for (int b = 0; b < 2; ++b)
#pragma unroll
            for (int m = 0; m < 4; ++m)
#pragma unroll
                for (int n = 0; n < 2; ++n) acc[a][b][m][n] = (f32x4){0.f, 0.f, 0.f, 0.f};
    bf16x8 At[4][2], B0[2][2], B1[2][2];
    const char* cA = g.a_ptr(cur); const char* cB = g.b_ptr(cur);
    PG8_STAGE(PG8_SB(0, 0), cB, voffB); PG8_STAGE(PG8_SB(0, 1), cB + hstepB, voffB); PG8_STAGE(PG8_SA(0, 0), cA, voffA); PG8_STAGE(PG8_SA(0, 1), cA + hstepA, voffA);
    if (wr == 1) PG8_BAR;
    PG8_WAIT_V(2); PG8_BAR;
    PG8_STAGE(PG8_SB(1, 0), cB + kstep, voffB); PG8_STAGE(PG8_SA(1, 0), cA + kstep, voffA); PG8_STAGE(PG8_SB(1, 1), cB + hstepB + kstep, voffB);
    PG8_WAIT_V(6); PG8_BAR;
    for (;;) {
        const bool has_next = S.next(ui + 1, nxt);
        const char* nA = has_next ? g.a_ptr(nxt) : cA; const char* nB = has_next ? g.b_ptr(nxt) : cB;
        for (int t = 0; t < nt; t += 2) {
            const bool last = (t == nt - 2);
            const char* a1 = cA + (size_t)(t + 1) * kstep;
            const char* a2 = last ? nA : cA + (size_t)(t + 2) * kstep; const char* b2 = last ? nB : cB + (size_t)(t + 2) * kstep;
            const char* a3 = a2 + kstep; const char* b3 = b2 + kstep;
            PG8_LDB(B0, 0, 0); PG8_LDB(B1, 0, 1); PG8_SCHED; PG8_LDA(At, 0, 0); PG8_STAGE(PG8_SA(1, 1), a1 + hstepA, voffA);
            PG8_WAIT_V(8); PG8_WAIT_L(0); PG8_BAR; PG8_MMA(0, 0, At, B0); PG8_MMA(0, 1, At, B1); PG8_BAR; PG8_SCHED;
            PG8_LDA(At, 0, 1); PG8_STAGE(PG8_SB(0, 0), b2, voffB); PG8_STAGE(PG8_SB(0, 1), b2 + hstepB, voffB); PG8_STAGE(PG8_SA(0, 0), a2, voffA);
            PG8_WAIT_V(8); PG8_WAIT_L(0); PG8_BAR; PG8_MMA(1, 0, At, B0); PG8_MMA(1, 1, At, B1); PG8_BAR; PG8_SCHED;
            PG8_LDB(B0, 1, 0); PG8_LDB(B1, 1, 1); PG8_SCHED; PG8_LDA(At, 1, 0); PG8_STAGE(PG8_SA(0, 1), a2 + hstepA, voffA);
            PG8_WAIT_V(8); PG8_WAIT_L(0); PG8_BAR; PG8_MMA(0, 0, At, B0); PG8_MMA(0, 1, At, B1); PG8_BAR; PG8_SCHED;
            PG8_LDA(At, 1, 1); PG8_STAGE(PG8_SB(1, 0), b3, voffB); PG8_STAGE(PG8_SB(1, 1), b3 + hstepB, voffB); PG8_STAGE(PG8_SA(1, 0), a3, voffA);
            PG8_WAIT_V(8); PG8_WAIT_L(0); PG8_BAR; PG8_MMA(1, 0, At, B0); PG8_MMA(1, 1, At, B1); PG8_BAR; PG8_SCHED;
        }
        if (wr == 0) PG8_BAR;
        if (g.wctr && ui == 0) split_wait(g.wctr, g.wtarget, g.wst);
        E(acc, cur, wr, wc, fr, fq);
        if (!has_next) break;
#pragma unroll
        for (int a = 0; a < 2; ++a)
#pragma unroll
            for (int b = 0; b < 2; ++b)
#pragma unroll
                for (int m = 0; m < 4; ++m)
#pragma unroll
                    for (int n = 0; n < 2; ++n) acc[a][b][m][n] = (f32x4){0.f, 0.f, 0.f, 0.f};
        cur = nxt; cA = nA; cB = nB; ++ui;
        if (wr == 1) PG8_BAR;
    }
    PG8_WAIT_V(0);
    PG8_BAR;
#undef PG8_SA
#undef PG8_SB
#undef PG8_STAGE
#undef PG8_LDA
#undef PG8_LDB
#undef PG8_MMA
#undef PG8_WAIT_V
#undef PG8_WAIT_L
#undef PG8_BAR
#undef PG8_SCHED
}

#define EPI_ARGS const f32x4 (&acc)[2][2][4][2], const Unit& u, int wr, int wc, int fr, int fq
struct EpiBf16Rs {
    static constexpr bool PERM = true;
    bf16_t* O; bf16_t* O2; int ldc; const float* rs; int split_pn;
    DI void operator()(EPI_ARGS) const {
        const int row0 = u.pm * BM + wr * 64 + fr; const bool second = u.pn >= split_pn;
        bf16_t* base = second ? O2 : O; const int col0 = (second ? u.pn - split_pn : u.pn) * BM + wc * 32 + 8 * fq;
        float rsv[8];
#pragma unroll
        for (int rg = 0; rg < 8; ++rg) rsv[rg] = rs[row0 + (rg >> 2) * HALF + (rg & 3) * 16];
#pragma unroll
        for (int ai = 0; ai < 2; ++ai)
#pragma unroll
            for (int m = 0; m < 4; ++m) { const int row = row0 + ai * HALF + m * 16; const float s = rsv[ai * 4 + m]; bf16_t* rowp = base + (size_t)row * ldc + col0;
#pragma unroll
                for (int bj = 0; bj < 2; ++bj) { f32x4 v0 = acc[ai][bj][m][0] * s, v1 = acc[ai][bj][m][1] * s;
                    if (second) {
#pragma unroll
                        for (int j = 0; j < 4; ++j) { v0[j] = siluf_(v0[j]); v1[j] = siluf_(v1[j]); } }
                    u32x4 w; w.x = cvt_pk_bf16(v0[0], v0[1]); w.y = cvt_pk_bf16(v0[2], v0[3]); w.z = cvt_pk_bf16(v1[0], v1[1]); w.w = cvt_pk_bf16(v1[2], v1[3]);
                    *(u32x4*)(rowp + bj * HALF) = w; }
                asm volatile("" ::: "memory"); }
    }
};
struct EpiGate {
    static constexpr bool PERM = true;
    const bf16_t* XC; bf16_t* LA; bf16_t* BIN; const float* brg; const float* big; const float* sp8;
    DI void operator()(EPI_ARGS) const {
        const int row0 = u.pm * BM + wr * 64 + fr; const int cb = (u.pn >> 1) * 256 + (u.pn & 1) * 128 + wc * 32 + 8 * fq;
        float sp[8]; unsigned bri[8];
        { const f32x4 a0 = *(const f32x4*)(brg + cb), a1 = *(const f32x4*)(brg + cb + 4), c0 = *(const f32x4*)(big + cb), c1 = *(const f32x4*)(big + cb + 4), s0 = *(const f32x4*)(sp8 + cb), s1 = *(const f32x4*)(sp8 + cb + 4);
#pragma unroll
          for (int j = 0; j < 4; ++j) { bri[j] = cvt_pk_bf16(a0[j], c0[j]); bri[4 + j] = cvt_pk_bf16(a1[j], c1[j]); sp[j] = s0[j]; sp[4 + j] = s1[j]; } }
        u32x4 xq[2];
#pragma unroll
        for (int rg = 0; rg < 2; ++rg) xq[rg] = *(const u32x4*)(XC + (size_t)(row0 + rg * 16) * DM + cb);
#pragma unroll
        for (int rg = 0; rg < 8; ++rg) { const int ai = rg >> 2, m = rg & 3; const int row = row0 + ai * HALF + m * 16; const size_t off = (size_t)row * DM + cb;
            const u32x4 xw = xq[rg & 1];
            if (rg < 6) xq[rg & 1] = *(const u32x4*)(XC + (size_t)(row0 + ((rg + 2) >> 2) * HALF + ((rg + 2) & 3) * 16) * DM + cb);
            float xc[8]; unpack8(xw, xc);
            const bool first = (row & (SEQ - 1)) == 0;
            float la[8], bi[8];
#pragma unroll
            for (int e = 0; e < 8; ++e) { const float ar = acc[ai][0][m][e >> 2][e & 3] + lo_bf(bri[e]), ag = acc[ai][1][m][e >> 2][e & 3] + hi_bf(bri[e]);
                const float r = sigmoidf_(ar), ig = sigmoidf_(ag); const float l = sp[e] * r; la[e] = l;
                const float a2 = fexp(2.f * l); const float mult = first ? 1.f : fsqrt(fmaxf(1.f - a2, 0.f)); bi[e] = mult * ig * xc[e]; }
            *(u32x4*)(LA + off) = pack8f(la); *(u32x4*)(BIN + off) = pack8f(bi);
            asm volatile("" ::: "memory"); }
    }
};
struct EpiRes {
    static constexpr bool PERM = false;
    const float* base; float* out; int ldc;
    DI void operator()(EPI_ARGS) const {
        const int row0 = u.pm * BM + wr * 64 + fr, col0 = u.pn * BM + wc * 32 + 4 * fq;
        f32x4 cur[4];
        { const size_t off = (size_t)row0 * ldc + col0;
#pragma unroll
          for (int q = 0; q < 4; ++q) cur[q] = *(const f32x4*)(base + off + (q >> 1) * HALF + (q & 1) * 16); }
#pragma unroll
        for (int rg = 0; rg < 8; ++rg) { const int ai = rg >> 2, m = rg & 3; const size_t off = (size_t)(row0 + ai * HALF + m * 16) * ldc + col0;
            f32x4 nx[4];
            if (rg < 7) { const size_t offn = (size_t)(row0 + ((rg + 1) >> 2) * HALF + ((rg + 1) & 3) * 16) * ldc + col0;
#pragma unroll
                for (int q = 0; q < 4; ++q) nx[q] = *(const f32x4*)(base + offn + (q >> 1) * HALF + (q & 1) * 16); }
#pragma unroll
            for (int q = 0; q < 4; ++q) *(f32x4*)(out + off + (q >> 1) * HALF + (q & 1) * 16) = cur[q] + acc[ai][q >> 1][m][q & 1];
            if (rg < 7) {
#pragma unroll
                for (int q = 0; q < 4; ++q) cur[q] = nx[q]; }
            asm volatile("" ::: "memory"); }
    }
};
template <bool F32OUT>
struct EpiXRes {
    static constexpr bool PERM = true;
    bf16_t* X; float* OF; float* part;
    DI void operator()(EPI_ARGS) const {
        const int row0 = u.pm * BM + wr * 64 + fr, col0 = u.pn * BM + wc * 32 + 8 * fq;
        u32x4 cur[2]; float ssv[8];
        { const size_t off = (size_t)row0 * DM + col0; cur[0] = *(const u32x4*)(X + off); cur[1] = *(const u32x4*)(X + off + HALF); }
#pragma unroll
        for (int rg = 0; rg < 8; ++rg) { const int ai = rg >> 2, m = rg & 3; const size_t off = (size_t)(row0 + ai * HALF + m * 16) * DM + col0;
            u32x4 nx[2];
            if (rg < 7) { const size_t offn = (size_t)(row0 + ((rg + 1) >> 2) * HALF + ((rg + 1) & 3) * 16) * DM + col0;
                nx[0] = *(const u32x4*)(X + offn); nx[1] = *(const u32x4*)(X + offn + HALF); }
            float ss = 0.f;
#pragma unroll
            for (int bj = 0; bj < 2; ++bj) { float v[8]; unpack8(cur[bj], v);
#pragma unroll
                for (int e = 0; e < 8; ++e) v[e] += acc[ai][bj][m][e >> 2][e & 3];
                if (F32OUT) { *(f32x4*)(OF + off + bj * HALF) = (f32x4){v[0], v[1], v[2], v[3]}; *(f32x4*)(OF + off + bj * HALF + 4) = (f32x4){v[4], v[5], v[6], v[7]}; }
                else {
#pragma unroll
                    for (int e = 0; e < 8; ++e) ss += v[e] * v[e];
                    *(u32x4*)(X + off + bj * HALF) = pack8f(v); } }
            ssv[rg] = ss;
            if (rg < 7) { cur[0] = nx[0]; cur[1] = nx[1]; }
            asm volatile("" ::: "memory"); }
        if (!F32OUT) {
#pragma unroll
            for (int rg = 0; rg < 8; ++rg) { float t = ssv[rg]; t += shx<16>(t); t = half_sum(t); ssv[rg] = t; }
            if (fq == 0) { float* pp = part + (size_t)(u.pn * 4 + wc) * MP + row0;
#pragma unroll
                for (int rg = 0; rg < 8; ++rg) pp[(rg >> 2) * HALF + (rg & 3) * 16] = ssv[rg]; } }
    }
};
struct EpiKV {
    static constexpr bool PERM = false;
    float* o_cmp; float* o_slc; float* o_win; const float* rs;
    DI void operator()(EPI_ARGS) const {
        float* dst = o_cmp + (size_t)(u.pn >> 2) * ((size_t)MP * 1024); if (u.pn >= 8) dst = o_win;
        const int row0 = u.pm * BM + wr * 64 + fr, col0 = (u.pn & 3) * BM + wc * 32 + 4 * fq;
        float rsv[8];
#pragma unroll
        for (int rg = 0; rg < 8; ++rg) rsv[rg] = rs[row0 + (rg >> 2) * HALF + (rg & 3) * 16];
#pragma unroll
        for (int ai = 0; ai < 2; ++ai)
#pragma unroll
            for (int m = 0; m < 4; ++m) { const int row = row0 + ai * HALF + m * 16; const float s = rsv[ai * 4 + m]; float* rowp = dst + (size_t)row * 1024 + col0;
#pragma unroll
                for (int bj = 0; bj < 2; ++bj)
#pragma unroll
                    for (int n = 0; n < 2; ++n) *(f32x4*)(rowp + bj * HALF + n * 16) = acc[ai][bj][m][n] * s;
                asm volatile("" ::: "memory"); }
    }
};
struct EpiPart {
    static constexpr bool PERM = false;
    float* P; size_t ks_stride; int ldc; int half_only;
    DI void operator()(EPI_ARGS) const {
        float* dst = P + (size_t)u.ks * ks_stride; const int row0 = u.pm * BM + wr * 64 + fr, col0 = wc * 32 + 4 * fq;
#pragma unroll
        for (int ai = 0; ai < 2; ++ai)
#pragma unroll
            for (int m = 0; m < 4; ++m) { float* rowp = dst + (size_t)(row0 + ai * HALF + m * 16) * ldc + col0;
#pragma unroll
                for (int bj = 0; bj < 2; ++bj) { if (bj == 1 && half_only) continue;
#pragma unroll
                    for (int n = 0; n < 2; ++n) *(f32x4*)(rowp + bj * HALF + n * 16) = acc[ai][bj][m][n]; } }
    }
};
struct EpiHidS {
    static constexpr bool PERM = true;
    bf16_t* O; const float* posb;
    DI void operator()(EPI_ARGS) const {
        const int row0 = u.pm * BM + wr * 64 + fr, col0 = wc * 32 + 8 * fq; const float* pb = posb + u.pn * 256;
        f32x4 bv[2][2];
#pragma unroll
        for (int bj = 0; bj < 2; ++bj)
#pragma unroll
            for (int n = 0; n < 2; ++n) bv[bj][n] = *(const f32x4*)(pb + col0 + bj * HALF + 4 * n);
#pragma unroll
        for (int ai = 0; ai < 2; ++ai)
#pragma unroll
            for (int m = 0; m < 4; ++m) { bf16_t* rowp = O + (size_t)(row0 + ai * HALF + m * 16) * 256 + col0;
#pragma unroll
                for (int bj = 0; bj < 2; ++bj) { f32x4 v0 = acc[ai][bj][m][0] + bv[bj][0], v1 = acc[ai][bj][m][1] + bv[bj][1];
#pragma unroll
                    for (int j = 0; j < 4; ++j) { v0[j] = siluf_(v0[j]); v1[j] = siluf_(v1[j]); }
                    u32x4 w; w.x = cvt_pk_bf16(v0[0], v0[1]); w.y = cvt_pk_bf16(v0[2], v0[3]); w.z = cvt_pk_bf16(v1[0], v1[1]); w.w = cvt_pk_bf16(v1[2], v1[3]);
                    *(u32x4*)(rowp + bj * HALF) = w; } }
    }
};
}

namespace att {
constexpr int SHM_T = 16384;
constexpr int V_OFF = 0, K_OFF = 2 * SHM_T, WSC_OFF = 4 * SHM_T, LUT_OFF = WSC_OFF + 8 * 64 * 4, REV_OFF = LUT_OFF + 8 * 132 * 4, REV_N = 296, REV_ZERO = 224, IMP_OFF = 81920,
    IMPX_OFF = IMP_OFF + 32768  , OT_OFF = IMP_OFF  , MASK_OFF = IMP_OFF + 65536, ATT_END = MASK_OFF + 128;
static_assert(REV_OFF + 8 * REV_N * 4 <= IMP_OFF && ATT_END <= LDS_MAIN, "attention LDS map");
#define KSWZ(row, colB) ((row) * 256 + ((colB) ^ (((row) & 7) << 4)))
DI int v_rd_base(int lane) { return ((lane & 3) << 3) | (((lane >> 2) & 3) << 6) | (((lane >> 4) & 1) << 5) | (((lane >> 5) & 1) << 8); }
constexpr int v_rd_off(int d0, int ks, int half) { return d0 * 512 + ks * 4096 + half * 2048; }
DI int crow(int r, int hi) { return (r & 3) + 8 * (r >> 2) + 4 * hi; }
DI float swap_max(float v) { return half_max(v); }
DI float swap_add(float v) { return half_sum(v); }

DI void pack_p(const f32x16& p0, const f32x16& p1, bf16x8& pa0, bf16x8& pa1, bf16x8& pa2, bf16x8& pa3) {
#define PK4(P, B_, OUT) do { unsigned a0 = cvt_pk_bf16(P[B_+0], P[B_+1]), a1 = cvt_pk_bf16(P[B_+2], P[B_+3]);                          \
        unsigned b0 = cvt_pk_bf16(P[B_+4], P[B_+5]), b1 = cvt_pk_bf16(P[B_+6], P[B_+7]);                                             \
        auto r0 = __builtin_amdgcn_permlane32_swap(a0, b0, false, false); auto r1 = __builtin_amdgcn_permlane32_swap(a1, b1, false, false); \
        u32x4 w = {r0[0], r1[0], r0[1], r1[1]}; OUT = *reinterpret_cast<bf16x8*>(&w); } while (0)
    PK4(p0, 0, pa0); PK4(p0, 8, pa1); PK4(p1, 0, pa2); PK4(p1, 8, pa3);
#undef PK4
}

struct Branch { const bf16_t* K; const bf16_t* V; unsigned long long tiles; int kshift, koff, dmax; };
struct Pos { int tid, wid, lane, r32, hi; unsigned kso[2], vso[2]; int vb0; };

DI void issue_tile(LAS unsigned char* lds, const Pos& P, const Branch& B, int j, int buf) {
    const char* ks = (const char*)B.K + (size_t)j * SHM_T; const char* vs = (const char*)B.V + (size_t)j * SHM_T;
#pragma unroll
    for (int i = 0; i < 2; ++i)
        __builtin_amdgcn_global_load_lds((const unsigned*)(ks + P.kso[i]), (LAS unsigned*)(lds + K_OFF + buf * SHM_T + (P.wid * 2 + i) * 1024), 16, 0, 0);
#pragma unroll
    for (int i = 0; i < 2; ++i)
        __builtin_amdgcn_global_load_lds((const unsigned*)(vs + P.vso[i]), (LAS unsigned*)(lds + V_OFF + buf * SHM_T + (P.wid * 2 + i) * 1024), 16, 0, 0);
}
DI int first_tile(unsigned long long tiles) { return tiles ? __builtin_ctzll(tiles) : -1; }
DI int next_tile(unsigned long long tiles, int j) { const unsigned long long m = (j >= 63) ? 0ull : (tiles >> (j + 1)); return m ? j + 1 + __builtin_ctzll(m) : -1; }

DI void qkt(f32x16& p0, f32x16& p1, LAS const unsigned char* Kb, int r32, int hi, const bf16x8* qr) {
    LAS const unsigned char* kb[4];
#pragma unroll
    for (int dd = 0; dd < 4; ++dd) kb[dd] = Kb + KSWZ(r32, (dd * 16 + hi * 8) * 2);
    bf16x8 fa[4][2], fb[4][2];
    __builtin_amdgcn_sched_barrier(0);
#pragma unroll
    for (int d0 = 0; d0 < 4; ++d0) { fa[d0][0] = *(LAS const bf16x8*)(kb[d0]); fa[d0][1] = *(LAS const bf16x8*)(kb[d0] + 32 * 256); }
#pragma unroll
    for (int d0 = 0; d0 < 4; ++d0) { fb[d0][0] = *(LAS const bf16x8*)(kb[d0] + 128); fb[d0][1] = *(LAS const bf16x8*)(kb[d0] + 128 + 32 * 256); }
    __builtin_amdgcn_sched_barrier(0);
    asm volatile("s_waitcnt lgkmcnt(8)" ::: "memory");
    __builtin_amdgcn_sched_barrier(0);
#pragma unroll
    for (int d0 = 0; d0 < 4; ++d0) { p0 = __builtin_amdgcn_mfma_f32_32x32x16_bf16(fa[d0][0], qr[d0], p0, 0, 0, 0); p1 = __builtin_amdgcn_mfma_f32_32x32x16_bf16(fa[d0][1], qr[d0], p1, 0, 0, 0); }
    __builtin_amdgcn_sched_barrier(0);
    asm volatile("s_waitcnt lgkmcnt(0)" ::: "memory");
    __builtin_amdgcn_sched_barrier(0);
#pragma unroll
    for (int d0 = 0; d0 < 4; ++d0) { p0 = __builtin_amdgcn_mfma_f32_32x32x16_bf16(fb[d0][0], qr[4 + d0], p0, 0, 0, 0); p1 = __builtin_amdgcn_mfma_f32_32x32x16_bf16(fb[d0][1], qr[4 + d0], p1, 0, 0, 0); }
    __builtin_amdgcn_sched_barrier(0);
}
DI void pv_tile(f32x16* o, int vb, bf16x8 pa0, bf16x8 pa1, bf16x8 pa2, bf16x8 pa3) {
#define TRRD(dst, off) asm volatile("ds_read_b64_tr_b16 %0, %1 offset:%2" : "=&v"(dst) : "v"(vb), "i"(off) : "memory")
#define PV_LD(ks, L, H) do { TRRD(L[0], v_rd_off(0, ks, 0)); TRRD(H[0], v_rd_off(0, ks, 1)); TRRD(L[1], v_rd_off(1, ks, 0)); TRRD(H[1], v_rd_off(1, ks, 1)); \
                             TRRD(L[2], v_rd_off(2, ks, 0)); TRRD(H[2], v_rd_off(2, ks, 1)); TRRD(L[3], v_rd_off(3, ks, 0)); TRRD(H[3], v_rd_off(3, ks, 1)); } while (0)
#define PV_MM(pa, L, H) do { _Pragma("unroll") for (int d0 = 0; d0 < 4; ++d0) \
        o[d0] = __builtin_amdgcn_mfma_f32_32x32x16_bf16(pa, (bf16x8){L[d0][0], L[d0][1], L[d0][2], L[d0][3], H[d0][0], H[d0][1], H[d0][2], H[d0][3]}, o[d0], 0, 0, 0); } while (0)
    s16x4 la[4], ha[4], lb[4], hb[4];
    PV_LD(0, la, ha);
    PV_LD(1, lb, hb);
    asm volatile("s_waitcnt lgkmcnt(8)" ::: "memory"); __builtin_amdgcn_sched_barrier(0);
    PV_MM(pa0, la, ha); __builtin_amdgcn_sched_barrier(0);
    PV_LD(2, la, ha);
    asm volatile("s_waitcnt lgkmcnt(8)" ::: "memory"); __builtin_amdgcn_sched_barrier(0);
    PV_MM(pa1, lb, hb); __builtin_amdgcn_sched_barrier(0);
    PV_LD(3, lb, hb);
    asm volatile("s_waitcnt lgkmcnt(8)" ::: "memory"); __builtin_amdgcn_sched_barrier(0);
    PV_MM(pa2, la, ha); __builtin_amdgcn_sched_barrier(0);
    asm volatile("s_waitcnt lgkmcnt(0)" ::: "memory"); __builtin_amdgcn_sched_barrier(0);
    PV_MM(pa3, lb, hb);
#undef PV_LD
#undef PV_MM
#undef TRRD
}

DI void softmax_pv(f32x16& p0, f32x16& p1, float off, f32x16* o, int vb, float& lsum) {
#define TRRD(dst, o_) asm volatile("ds_read_b64_tr_b16 %0, %1 offset:%2" : "=&v"(dst) : "v"(vb), "i"(o_) : "memory")
#define PV_LD(ks, L, H) do { TRRD(L[0], v_rd_off(0, ks, 0)); TRRD(H[0], v_rd_off(0, ks, 1)); TRRD(L[1], v_rd_off(1, ks, 0)); TRRD(H[1], v_rd_off(1, ks, 1)); \
                             TRRD(L[2], v_rd_off(2, ks, 0)); TRRD(H[2], v_rd_off(2, ks, 1)); TRRD(L[3], v_rd_off(3, ks, 0)); TRRD(H[3], v_rd_off(3, ks, 1)); } while (0)
#define PV_MM(pa, L, H) do { _Pragma("unroll") for (int d0 = 0; d0 < 4; ++d0) \
        o[d0] = __builtin_amdgcn_mfma_f32_32x32x16_bf16(pa, (bf16x8){L[d0][0], L[d0][1], L[d0][2], L[d0][3], H[d0][0], H[d0][1], H[d0][2], H[d0][3]}, o[d0], 0, 0, 0); } while (0)
#define SM_CHUNK(P, B_, OUT) do { _Pragma("unroll") for (int e_ = 0; e_ < 8; ++e_) { P[B_ + e_] = __builtin_amdgcn_exp2f(P[B_ + e_] + off); ps += P[B_ + e_]; } \
        unsigned a0 = cvt_pk_bf16(P[B_+0], P[B_+1]), a1 = cvt_pk_bf16(P[B_+2], P[B_+3]), b0 = cvt_pk_bf16(P[B_+4], P[B_+5]), b1 = cvt_pk_bf16(P[B_+6], P[B_+7]); \
        auto r0 = __builtin_amdgcn_permlane32_swap(a0, b0, false, false); auto r1 = __builtin_amdgcn_permlane32_swap(a1, b1, false, false); \
        u32x4 w_ = {r0[0], r1[0], r0[1], r1[1]}; OUT = *reinterpret_cast<bf16x8*>(&w_); } while (0)
    s16x4 la[4], ha[4], lb[4], hb[4]; float ps = 0.f; bf16x8 pa;
    PV_LD(0, la, ha); PV_LD(1, lb, hb);
    __builtin_amdgcn_sched_barrier(0);
    SM_CHUNK(p0, 0, pa);
    asm volatile("s_waitcnt lgkmcnt(8)" ::: "memory"); __builtin_amdgcn_sched_barrier(0);
    PV_MM(pa, la, ha); __builtin_amdgcn_sched_barrier(0);
    PV_LD(2, la, ha);
    SM_CHUNK(p0, 8, pa);
    asm volatile("s_waitcnt lgkmcnt(8)" ::: "memory"); __builtin_amdgcn_sched_barrier(0);
    PV_MM(pa, lb, hb); __builtin_amdgcn_sched_barrier(0);
    PV_LD(3, lb, hb);
    SM_CHUNK(p1, 0, pa);
    asm volatile("s_waitcnt lgkmcnt(8)" ::: "memory"); __builtin_amdgcn_sched_barrier(0);
    PV_MM(pa, la, ha); __builtin_amdgcn_sched_barrier(0);
    SM_CHUNK(p1, 8, pa);
    asm volatile("s_waitcnt lgkmcnt(0)" ::: "memory"); __builtin_amdgcn_sched_barrier(0);
    PV_MM(pa, lb, hb);
    lsum += swap_add(ps);
#undef SM_CHUNK
#undef PV_MM
#undef PV_LD
#undef TRRD
}

template <bool CMP>
DI void do_tile(LAS unsigned char* lds, const Pos& P, const Branch& B, int j, int buf, int t0, int tq, bool rowok, const bf16x8* qr, f32x16* o, float& lsum, float mub) {
    LAS const float* lutw = (LAS const float*)(lds + LUT_OFF) + P.wid * 132;
    LAS const unsigned char* Kb = (LAS const unsigned char*)(lds + K_OFF + buf * SHM_T);
    const float NEG = -__builtin_inff();
    const int kmin = (j * 64) << B.kshift, kmax = (j * 64 + 63) << B.kshift;
    const int dlo = (t0 - B.koff) - kmax, dhi = (t0 + 31 - B.koff) - kmin;
    f32x16 p0, p1; float off;
    if (dlo >= 128 && dhi <= B.dmax) {
        off = rowok ? lutw[128] - mub : NEG;
#pragma unroll
        for (int r = 0; r < 16; ++r) { p0[r] = 0.f; p1[r] = 0.f; }
        qkt(p0, p1, Kb, P.r32, P.hi, qr);
    } else if (B.kshift == 0 && dhi <= B.dmax) {
        off = rowok ? -mub : NEG;
        LAS const float* rv = (LAS const float*)(lds + REV_OFF) + P.wid * REV_N + (REV_ZERO - (tq - j * 64 - 4 * P.hi));
#pragma unroll
        for (int r = 0; r < 16; ++r) { const int c = (r & 3) + 8 * (r >> 2); p0[r] = rv[c]; p1[r] = rv[c + 32]; }
        qkt(p0, p1, Kb, P.r32, P.hi, qr);
    } else {
        off = rowok ? -mub : NEG;
        const int dq = tq - (((j * 64) + 4 * P.hi) << B.kshift);
#pragma unroll
        for (int r = 0; r < 16; ++r) { const int c = (r & 3) + 8 * (r >> 2);
            const int d0 = dq - (c << B.kshift), d1 = dq - ((c + 32) << B.kshift);
            p0[r] = lutw[min(max(d0, 0), 128)]; p1[r] = lutw[min(max(d1, 0), 128)]; }
        asm volatile("s_waitcnt lgkmcnt(0)" ::: "memory");
#pragma unroll
        for (int r = 0; r < 16; ++r) { const int c = (r & 3) + 8 * (r >> 2);
            const int d0 = dq - (c << B.kshift), d1 = dq - ((c + 32) << B.kshift);
            p0[r] = ((unsigned)d0 <= (unsigned)B.dmax) ? p0[r] : NEG;
            p1[r] = ((unsigned)d1 <= (unsigned)B.dmax) ? p1[r] : NEG; }
        qkt(p0, p1, Kb, P.r32, P.hi, qr);
    }
    if (!CMP) { softmax_pv(p0, p1, off, o, P.vb0 + buf * SHM_T, lsum); return; }
#pragma unroll
    for (int r = 0; r < 16; ++r) { p0[r] = __builtin_amdgcn_exp2f(p0[r] + off); p1[r] = __builtin_amdgcn_exp2f(p1[r] + off); }
    float ps = 0.f;
#pragma unroll
    for (int r = 0; r < 16; ++r) ps += p0[r] + p1[r];
    lsum += swap_add(ps);
    if (CMP) {
        LAS float* impw = (LAS float*)(lds + IMP_OFF) + (P.wid * 32 + P.r32) * 32 + j * 16 + P.hi;
        float prev = 0.f;
#pragma unroll
        for (int x = 0; x < 8; ++x) { const int gq = x & 3; const f32x16& pp = x < 4 ? p0 : p1;
            const float ownv = pp[4 * gq] + pp[4 * gq + 1] + pp[4 * gq + 2] + 0.5f * pp[4 * gq + 3], nx = 0.5f * pp[4 * gq + 3];
            const float recv = half_other(nx, P.hi);
            impw[2 * x] = ownv + (P.hi ? recv : prev); prev = recv;
            if (x == 7 && P.hi && j == 0) ((LAS float*)(lds + IMPX_OFF))[P.wid * 32 + P.r32] = nx; }
    }
    bf16x8 pa0, pa1, pa2, pa3;
    pack_p(p0, p1, pa0, pa1, pa2, pa3);
    pv_tile(o, P.vb0 + buf * SHM_T, pa0, pa1, pa2, pa3);
}
template <bool CMP>
DI void run_branch(LAS unsigned char* lds, const Pos& P, const Branch& B, int& buf, const Branch& NB, int nj, int t0, unsigned rowmask, const bf16x8* qr, f32x16* o, float& lsum, float mub) {
    int j = first_tile(B.tiles);
    const int tq = t0 + P.r32 - B.koff;
    while (j >= 0) {
        asm volatile("s_waitcnt vmcnt(0)" ::: "memory"); __builtin_amdgcn_s_barrier();
        const int jn = next_tile(B.tiles, j);
        if (jn >= 0) issue_tile(lds, P, B, jn, buf ^ 1); else if (nj >= 0) issue_tile(lds, P, NB, nj, buf ^ 1);
        do_tile<CMP>(lds, P, B, j, buf, t0, tq, (rowmask >> (j & 31)) & 1u, qr, o, lsum, mub);
        asm volatile("s_waitcnt lgkmcnt(0)" ::: "memory");
        buf ^= 1; j = jn;
    }
}
template <int STAGE>
DI void fold_branch(LAS unsigned char* lds, const Pos& P, f32x16* o, float fac) {
    LAS float* wsc = (LAS float*)(lds + WSC_OFF) + P.wid * 64; LAS unsigned* otl = (LAS unsigned*)(lds + OT_OFF + P.wid * 8192) + P.lane;
    if (P.hi == 0) wsc[P.r32] = fac;
    asm volatile("s_waitcnt lgkmcnt(0)" ::: "memory");
    float fv[16];
#pragma unroll
    for (int r = 0; r < 16; ++r) fv[r] = wsc[crow(r, P.hi)];
#pragma unroll
    for (int dh = 0; dh < 4; dh += 2) { unsigned wv[16];
        if (STAGE > 0) {
#pragma unroll
            for (int q = 0; q < 16; ++q) wv[q] = otl[(dh * 8 + q) * 64]; }
        __builtin_amdgcn_sched_barrier(0);
#pragma unroll
        for (int r = 0; r < 16; r += 2) { const float f0 = fv[r], f1 = fv[r + 1];
#pragma unroll
            for (int d_ = dh; d_ < dh + 2; ++d_) { float a = o[d_][r] * f0, b = o[d_][r + 1] * f1; LAS unsigned* wp = otl + (d_ * 8 + (r >> 1)) * 64;
                if (STAGE > 0) { const unsigned w = wv[(d_ - dh) * 8 + (r >> 1)]; a += lo_bf(w); b += hi_bf(w); }
                if (STAGE < 2) { *wp = cvt_pk_bf16(a, b); o[d_][r] = 0.f; o[d_][r + 1] = 0.f; } else { o[d_][r] = a; o[d_][r + 1] = b; } } }
        __builtin_amdgcn_sched_barrier(0); }
}

struct Tensors {
    const bf16_t* UQ; const bf16_t* SG; const float* BGP; const float* rs; const float* gate_bias; const float* qnorm; const float* knorm; const float* lutG;
    const bf16_t *KCP, *VCP, *SLCK, *SLCV, *WINK, *WINV; bf16_t* AO;
};
DI void attn_unit(LAS unsigned char* lds, const Tensors& T, int b, int g, int qt, unsigned* qctr, volatile LAS unsigned* qslot) {
    Pos P; P.tid = tid_now(lds); asm volatile("" : "+v"(P.tid)); P.wid = __builtin_amdgcn_readfirstlane(P.tid >> 6); P.lane = P.tid & 63; P.r32 = P.lane & 31; P.hi = P.lane >> 5;
#pragma unroll
    for (int i = 0; i < 2; ++i) { const int pc = P.wid * 2 + i;
        { const int row = pc * 4 + (P.lane >> 4), cpos = P.lane & 15; P.kso[i] = (unsigned)(row * 256 + ((cpos ^ (row & 7)) << 4)); }
        { const int q = pc * 64 + P.lane, sub = q >> 5, kk = (sub >> 2) * 8 + ((q >> 2) & 7), c = (sub & 3) * 32 + (q & 3) * 8;
          const int k = (kk & ~0xC) | ((kk & 4) << 1) | ((kk & 8) >> 1); P.vso[i] = (unsigned)(k * 256 + c * 2); } }
    P.vb0 = (int)(unsigned)(uintptr_t)(lds + V_OFF) + v_rd_base(P.lane);
    const int t0 = qt * 32, rowg0 = b * SEQ + t0, head = g * RPG + P.wid, slab = b * NKV + g;
    { Branch B0_; B0_.K = T.KCP + (size_t)slab * 128 * HD; B0_.V = T.VCP + (size_t)slab * 128 * HD; issue_tile(lds, P, B0_, 0, 0); }
    float lutv[3], revv[5]; int revd[5];
#pragma unroll
    for (int j = 0; j < 3; ++j) { const int i = P.tid + j * 512; lutv[j] = i < 8 * 132 ? T.lutG[g * 8 * 132 + i] : 0.f; }
#pragma unroll
    for (int j = 0; j < 5; ++j) { const int i = P.tid + j * 512; const int ii = i < 8 * REV_N ? i : 0; const int w = ii / REV_N, d = REV_ZERO - (ii - w * REV_N); revd[j] = d;
        revv[j] = T.lutG[(g * 8 + w) * 132 + (d < 0 ? 0 : (d < 128 ? d : 128))]; }
    const float* lgp = T.lutG + (g * 8 + P.wid) * 132;
    const float qn_a = T.qnorm[P.lane], qn_b = T.qnorm[64 + P.lane], lg_a = lgp[P.lane], lg_b = lgp[64 + P.lane], lg_c = lgp[128];
    float kn_a[3], kn_b[3];
#pragma unroll
    for (int k = 0; k < 3; ++k) { kn_a[k] = T.knorm[k * HD + P.lane]; kn_b[k] = T.knorm[k * HD + 64 + P.lane]; }
    u32x4 qw[8]; f32x4 qn0[8], qn1[8];
    { const bf16_t* qp = T.UQ + (size_t)(rowg0 + P.r32) * DM + head * HD + P.hi * 8;
#pragma unroll
      for (int d0 = 0; d0 < 8; ++d0) { qw[d0] = *(const u32x4*)(qp + d0 * 16); qn0[d0] = *(const f32x4*)(T.qnorm + d0 * 16 + P.hi * 8); qn1[d0] = *(const f32x4*)(T.qnorm + d0 * 16 + P.hi * 8 + 4); } }
    float bgp[3][8], gbias[3];
    const size_t rowg = (size_t)(rowg0 + P.r32); const float rsv = T.rs[rowg];
#pragma unroll
    for (int k = 0; k < 3; ++k) { gbias[k] = T.gate_bias[head * 3 + k];
#pragma unroll
        for (int ks = 0; ks < 8; ++ks) bgp[k][ks] = T.BGP[((size_t)ks * MP + rowg) * 128 + head * 3 + k]; }
    __builtin_amdgcn_sched_barrier(0);
#pragma unroll
    for (int j = 0; j < 3; ++j) { const int i = P.tid + j * 512; if (i < 8 * 132) ((LAS float*)(lds + LUT_OFF))[i] = lutv[j]; }
#pragma unroll
    for (int j = 0; j < 5; ++j) { const int i = P.tid + j * 512; if (i < 8 * REV_N) ((LAS float*)(lds + REV_OFF))[i] = revd[j] < 0 ? -__builtin_inff() : revv[j]; }
    float mub[3];
    { const float gq = wave_max(fmaxf(fabsf(qn_a), fabsf(qn_b)));
      const float lm = wave_max(fmaxf(fmaxf(lg_a, lg_b), lg_c));
#pragma unroll
      for (int k = 0; k < 3; ++k) { const float gk = wave_max(fmaxf(fabsf(kn_a[k]), fabsf(kn_b[k])));
          mub[k] = 11.3137085f * LOG2E * 1.001f * gq * gk + lm + 0.05f; } }
    bf16x8 qr[8];
    { float qv[8][8]; float ss = 0.f;
#pragma unroll
      for (int d0 = 0; d0 < 8; ++d0) { unpack8(qw[d0], qv[d0]);
#pragma unroll
          for (int e = 0; e < 8; ++e) ss += qv[d0][e] * qv[d0][e]; }
      ss = swap_add(ss);
      const float sc = frsq(ss * (1.f / HD) + EPS) * 0.08838834764831845f * LOG2E;
#pragma unroll
      for (int d0 = 0; d0 < 8; ++d0) { const f32x4 n0 = qn0[d0], n1 = qn1[d0];
          float v[8];
#pragma unroll
          for (int e = 0; e < 4; ++e) { v[e] = qv[d0][e] * sc * n0[e]; v[4 + e] = qv[d0][4 + e] * sc * n1[e]; }
          const u32x4 w = pack8f(v); qr[d0] = *reinterpret_cast<const bf16x8*>(&w); } }
    float bgv[3];
#pragma unroll
    for (int k = 0; k < 3; ++k) { float s_ = 0.f;
#pragma unroll
        for (int ks = 0; ks < 8; ++ks) s_ += bgp[k][ks];
        bgv[k] = sigmoidf_(s_ * rsv + gbias[k]); }
    asm volatile("" : "+v"(bgv[0]), "+v"(bgv[1]), "+v"(bgv[2]));
    f32x16 o[4];
#pragma unroll
    for (int d_ = 0; d_ < 4; ++d_)
#pragma unroll
        for (int r = 0; r < 16; ++r) o[d_][r] = 0.f;
    const int cur = t0 >> 6;
    const bool need_sel = t0 >= 1024;
    Branch BC, BS, BW;
    BC.K = T.KCP + (size_t)slab * 128 * HD; BC.V = T.VCP + (size_t)slab * 128 * HD; BC.kshift = 4; BC.koff = 31; BC.dmax = 0x3fffffff; BC.tiles = ((t0 >> 4) + 1) > 64 ? 3ull : 1ull;
    BS.K = T.SLCK + (size_t)slab * SEQ * HD; BS.V = T.SLCV + (size_t)slab * SEQ * HD; BS.kshift = 0; BS.koff = 0; BS.dmax = 0x3fffffff; BS.tiles = 1ull;
    BW.K = T.WINK + (size_t)slab * SEQ * HD; BW.V = T.WINV + (size_t)slab * SEQ * HD; BW.kshift = 0; BW.koff = 0; BW.dmax = 512;
    { const int jlo = t0 > 512 ? (t0 - 512) >> 6 : 0; BW.tiles = ((2ull << cur) - 1ull) & ~((1ull << jlo) - 1ull); }
    asm volatile("s_waitcnt vmcnt(0) lgkmcnt(0)" ::: "memory"); __builtin_amdgcn_s_barrier();
    int buf = 0;
    float fac_c;
    {
        float lsum = 0.f;
        run_branch<true>(lds, P, BC, buf, BS, 0, t0, 0xffffffffu, qr, o, lsum, mub[0]);
        const float inv = lsum > 0.f ? frcp(lsum) : 0.f;
        fac_c = bgv[0] * inv;
        if (P.hi == 0) ((LAS float*)(lds + IMPX_OFF))[256 + P.wid * 32 + P.r32] = inv;
    }
    asm volatile("s_waitcnt lgkmcnt(0)" ::: "memory"); __builtin_amdgcn_s_barrier();
    {
        LAS unsigned* selm = (LAS unsigned*)(lds + MASK_OFF);
        if (need_sel) {
#pragma unroll
            for (int pass = 0; pass < 2; ++pass) { const int q = P.wid * 4 + pass * 2 + P.hi, jb = P.r32; float v = 0.f;
                float raw_[8], car_[8], inv_[8];
#pragma unroll
                for (int w = 0; w < 8; ++w) { LAS const float* xs_ = (LAS const float*)(lds + IMPX_OFF); raw_[w] = ((LAS const float*)(lds + IMP_OFF))[(w * 32 + q) * 32 + jb]; car_[w] = xs_[w * 32 + q]; inv_[w] = xs_[256 + w * 32 + q]; }
                __builtin_amdgcn_sched_barrier(0);
#pragma unroll
                for (int w = 0; w < 8; ++w) v += (raw_[w] + (jb == 16 ? car_[w] : 0.f)) * inv_[w];
                const int cq = (t0 + q) >> 6; const bool forced = (jb == 0) || (jb == cq) || (jb == cq - 1), allowed = jb <= cq;
                const float score = forced ? 1e30f : (allowed ? v : -1e30f);
                int rank = 0;
#pragma unroll
                for (int k0 = 0; k0 < 32; k0 += 16) { float sk[16];
#pragma unroll
                    for (int u = 0; u < 16; ++u) sk[u] = __int_as_float(__builtin_amdgcn_ds_bpermute(((P.lane & 32) + k0 + u) << 2, __float_as_int(score)));
                    __builtin_amdgcn_sched_barrier(0);
#pragma unroll
                    for (int u = 0; u < 16; ++u) rank += (sk[u] > score || (sk[u] == score && k0 + u < jb)) ? 1 : 0;
                    __builtin_amdgcn_sched_barrier(0); }
                const unsigned long long bal = __ballot(rank < 16 && allowed);
                if (P.r32 == 0) selm[q] = P.hi ? (unsigned)(bal >> 32) : (unsigned)bal; }
        } else if (P.tid < 32) { const int cq = (t0 + P.tid) >> 6; selm[P.tid] = (2u << cq) - 1u; }
    }
    asm volatile("s_waitcnt lgkmcnt(0)" ::: "memory"); __builtin_amdgcn_s_barrier();
    fold_branch<0>(lds, P, o, fac_c);
    {
        const unsigned mymask = ((LAS const unsigned*)(lds + MASK_OFF))[P.r32];
        unsigned un = mymask;
        un |= shxu<1>(un); un |= shxu<2>(un); un |= shxu<4>(un); un |= shxu<8>(un); un |= shxu<16>(un);
        BS.tiles = (unsigned long long)(un & ((2u << cur) - 1u)) | 1ull;
        float lsum = 0.f;
        run_branch<false>(lds, P, BS, buf, BW, first_tile(BW.tiles), t0, mymask, qr, o, lsum, mub[1]);
        fold_branch<1>(lds, P, o, lsum > 0.f ? bgv[1] * frcp(lsum) : 0.f);
    }
    {
        float lsum = 0.f;
        run_branch<false>(lds, P, BW, buf, BW, -1, t0, 0xffffffffu, qr, o, lsum, mub[2]);
        fold_branch<2>(lds, P, o, lsum > 0.f ? bgv[2] * frcp(lsum) : 0.f);
    }
    asm volatile("s_waitcnt lgkmcnt(0)" ::: "memory"); __builtin_amdgcn_s_barrier();
    unsigned nxt_unit = 0;
    if (P.tid == 0) nxt_unit = __hip_atomic_fetch_add(qctr, 1u, __ATOMIC_RELAXED, __HIP_MEMORY_SCOPE_AGENT);
    {
        LAS float* stg = (LAS float*)(lds + P.wid * 16384);
        u32x4 gwv[8];
#pragma unroll
        for (int it = 0; it < 8; ++it) { const int gid = it * 64 + P.lane, row = gid >> 4, c8 = gid & 15; gwv[it] = *(const u32x4*)(T.SG + (size_t)(rowg0 + row) * DM + head * HD + c8 * 8); }
        __builtin_amdgcn_sched_barrier(0);
#pragma unroll
        for (int d_ = 0; d_ < 4; ++d_)
#pragma unroll
            for (int r = 0; r < 16; ++r) stg[crow(r, P.hi) * 128 + d_ * 32 + P.r32] = o[d_][r];
        asm volatile("s_waitcnt lgkmcnt(0)" ::: "memory");
#pragma unroll
        for (int it = 0; it < 8; ++it) { const int gid = it * 64 + P.lane, row = gid >> 4, c8 = gid & 15;
            const f32x4 a = *(LAS const f32x4*)(stg + row * 128 + c8 * 8), c = *(LAS const f32x4*)(stg + row * 128 + c8 * 8 + 4);
            const size_t off = (size_t)(rowg0 + row) * DM + head * HD + c8 * 8;
            const u32x4 gw = gwv[it]; float gv[8]; unpack8(gw, gv);
            float v[8];
#pragma unroll
            for (int e = 0; e < 4; ++e) { v[e] = a[e] * gv[e]; v[4 + e] = c[e] * gv[4 + e]; }
            *(u32x4*)(T.AO + off) = pack8f(v); }
    }
    if (P.tid == 0) *qslot = nxt_unit;
    asm volatile("s_waitcnt lgkmcnt(0)" ::: "memory"); __builtin_amdgcn_s_barrier();
}
}

struct Args { const float* in[30]; float* out; unsigned char* ws; int ph_lo, ph_hi; };
struct Ctx {
    LAS unsigned char* lds; const float* const* in; float* out; unsigned char* ws; float* sm;
    int tid, lane, wave, vcu, G;
};
DI Ctx reopaque(Ctx C) { C.tid = tid_now(C.lds); asm volatile("" : "+v"(C.tid)); C.lane = C.tid & 63; C.wave = __builtin_amdgcn_readfirstlane(C.tid >> 6); asm volatile("" : "+s"(C.vcu), "+s"(C.G)); { size_t z_ = 0; asm volatile("" : "+s"(z_)); C.ws += z_; C.sm = (float*)((unsigned char*)C.sm + z_); C.out = (float*)((unsigned char*)C.out + z_); } return C; }
DI int rel_bucket_dev(int d) { if (d < 16) return d; const int v = 16 + (int)(__logf((float)d * (1.f / 16.f)) / __logf(8.f) * 16.f); return v < 31 ? v : 31; }

template <int NSUB = 2, class F>
DI void skinny_gemm(const Ctx& C, const bf16_t* A, int lda, const bf16_t* Bt, int ldb, int N, int K, int ablk, F&& outf) {
    constexpr int KS = 8 / NSUB;
    const int ngroups = N / 16, npairs = (ngroups + NSUB - 1) / NSUB, sub = C.wave / KS, kq4 = C.wave % KS, i = C.lane & 15, kq = C.lane >> 4;
    const int kw = K / KS, steps = kw / 32;
    LAS float* red = (LAS float*)C.lds;
    for (int gp = C.vcu; gp < npairs; gp += C.G) {
        const int grp = gp * NSUB + sub; const bool valid = grp < ngroups; const int col0 = grp * 16;
        f32x4 acc = {0.f, 0.f, 0.f, 0.f};
        if (valid) {
            const bf16_t* ap = A + (size_t)(i & 7) * lda + (ablk ? (col0 >> 9) * 256 : 0) + kq4 * kw + kq * 8;
            const bf16_t* bp = Bt + (size_t)(col0 + i) * ldb + kq4 * kw + kq * 8;
            bf16x8 a0[8], b0[8], a1[8], b1[8];
#define SK_LD(A_, B_, g_) do { _Pragma("unroll") for (int u = 0; u < 8; ++u) if ((g_) * 8 + u < steps) { A_[u] = *(const bf16x8*)(ap + ((g_) * 8 + u) * 32); B_[u] = *(const bf16x8*)(bp + ((g_) * 8 + u) * 32); } } while (0)
#define SK_MM(A_, B_, g_) do { _Pragma("unroll") for (int u = 0; u < 8; ++u) if ((g_) * 8 + u < steps) acc = __builtin_amdgcn_mfma_f32_16x16x32_bf16(A_[u], B_[u], acc, 0, 0, 0); } while (0)
            const int ng = (steps + 7) >> 3;
            SK_LD(a0, b0, 0);
#pragma unroll 1
            for (int g = 0; g < ng; g += 2) {
                if (g + 1 < ng) SK_LD(a1, b1, g + 1);
                __builtin_amdgcn_sched_barrier(0);
                SK_MM(a0, b0, g);
                __builtin_amdgcn_sched_barrier(0);
                if (g + 2 < ng) SK_LD(a0, b0, g + 2);
                __builtin_amdgcn_sched_barrier(0);
                if (g + 1 < ng) SK_MM(a1, b1, g + 1);
                __builtin_amdgcn_sched_barrier(0);
            }
#undef SK_LD
#undef SK_MM
            asm volatile("s_nop 7\n\ts_nop 7" ::: "memory");
        }
        *(LAS f32x4*)(red + C.wave * 256 + C.lane * 4) = acc;
        __syncthreads();
        if (C.tid < 128 * NSUB) { const int sb = C.tid >> 7, idx = C.tid & 127, row = idx >> 4, col = idx & 15, g2 = gp * NSUB + sb;
            if (g2 < ngroups) { const int l2 = (row >> 2) * 16 + col, v = row & 3; float s = 0.f;
#pragma unroll
                for (int q = 0; q < KS; ++q) s += red[(sb * KS + q) * 256 + l2 * 4 + v];
                outf(row, g2 * 16 + col, s); } }
        __syncthreads();
    }
}

struct TrDesc { const float* W; const float* gain; bf16_t* dst; int ldw, k0, n0, nvalid, ldk, drow0; };
DI void tr_load(const TrDesc& d, int lane, float (&v)[64]) {
    if (lane < d.nvalid) { const float* wp = d.W + (size_t)d.k0 * d.ldw + d.n0 + lane;
#pragma unroll
        for (int i = 0; i < 64; ++i) v[i] = __builtin_nontemporal_load(wp + (size_t)i * d.ldw); }
}
DI void tr_store(const TrDesc& d, int lane, float (&v)[64]) {
    if (lane < d.nvalid) {
        if (d.gain) {
#pragma unroll
            for (int i = 0; i < 64; ++i) v[i] *= d.gain[d.k0 + i]; }
        bf16_t* dp = d.dst + (size_t)(d.drow0 + lane) * d.ldk + d.k0;
#pragma unroll
        for (int i = 0; i < 8; ++i) *(u32x4*)(dp + i * 8) = pack8f(v + i * 8); }
}
DI void norm_row(const float* x, bf16_t* xb, float* rs, int lane, const bf16_t* y = nullptr, float* xnew = nullptr) {
    f32x4 v[16]; float ss = 0.f;
#pragma unroll
    for (int j = 0; j < 16; ++j) v[j] = *(const f32x4*)(x + j * 256 + lane * 4);
    if (y) {
        u32x2 yw[16];
#pragma unroll
        for (int j = 0; j < 16; ++j) yw[j] = *(const u32x2*)(y + j * 256 + lane * 4);
#pragma unroll
        for (int j = 0; j < 16; ++j) { v[j][0] += lo_bf(yw[j].x); v[j][1] += hi_bf(yw[j].x); v[j][2] += lo_bf(yw[j].y); v[j][3] += hi_bf(yw[j].y); *(f32x4*)(xnew + j * 256 + lane * 4) = v[j]; } }
#pragma unroll
    for (int j = 0; j < 16; ++j) ss += v[j][0] * v[j][0] + v[j][1] * v[j][1] + v[j][2] * v[j][2] + v[j][3] * v[j][3];
    ss = wave_sum(ss);
    if (lane == 0) *rs = frsq(ss * (1.f / DM) + EPS);
#pragma unroll
    for (int j = 0; j < 16; ++j) { u32x2 w; w.x = cvt_pk_bf16(v[j][0], v[j][1]); w.y = cvt_pk_bf16(v[j][2], v[j][3]); *(u32x2*)(xb + j * 256 + lane * 4) = w; }
}
constexpr int C1 = 2 * 8192, C2 = 1024, C3 = 2 * 4096, C4 = 3072, C5 = 2 * 8320, C6 = 2 * 4096, C7 = 2 * 256, C8 = 16, C9 = 32768, C10 = MP + NSMP, C11 = 128, C12 = 128, C13 = 66, C14 = 320;
constexpr int T_W1T = 0, T_WGT = T_W1T + C1, T_W2T = T_WGT + C2, T_WKV = T_W2T + C3, T_WIN = T_WKV + C4, T_WOUT = T_WIN + C5, T_WC1 = T_WOUT + C6, T_WC2 = T_WC1 + C7, T_CACHE = T_WC2 + C8,
    T_NORM = T_CACHE + C9, T_SP8 = T_NORM + C10, T_POSB = T_SP8 + C11, T_LUT = T_POSB + C12, T_PAD = T_LUT + C13, T_END = T_PAD + C14;
DI void tr_decode(const Ctx& C, int r, TrDesc& d) {
    unsigned char* ws = C.ws; int kt, nt; d.nvalid = 64; d.ldk = DM; d.gain = nullptr;
    if (r < T_WGT) { const int L = r >> 13, q = r & 8191; kt = q >> 7; nt = q & 127; d.W = C.in[9] + (size_t)L * DM * 8192; d.ldw = 8192; d.gain = C.in[8] + L * DM; d.dst = (bf16_t*)(ws + WS_W1T) + (size_t)L * 8192 * DM; d.drow0 = nt * 64; }
    else if (r < T_W2T) { r -= T_WGT; const int L = r >> 9, q = r & 511, blk = q >> 5, gi = (q >> 4) & 1; kt = (q >> 2) & 3; nt = q & 3; d.W = C.in[gi ? 14 : 12] + (size_t)(L * 16 + blk) * 65536; d.ldw = 256; d.ldk = 256;
        d.dst = (bf16_t*)(ws + WS_WGT) + (size_t)L * 8192 * 256; d.drow0 = (blk * 2 + ((nt * 64) >> 7)) * 256 + gi * 128 + ((nt * 64) & 127); }
    else if (r < T_WKV) { r -= T_W2T; const int L = r >> 12, q = r & 4095; kt = q >> 6; nt = q & 63; d.W = C.in[17] + (size_t)L * DM * DM; d.ldw = DM; d.dst = (bf16_t*)(ws + WS_W2T) + (size_t)L * DM * DM; d.drow0 = nt * 64; }
    else if (r < T_WIN) { r -= T_WKV; kt = r / 48; nt = r % 48; d.W = C.in[19]; d.ldw = 3072; d.gain = C.in[18]; d.dst = (bf16_t*)(ws + WS_WKVT); d.drow0 = nt * 64; }
    else if (r < T_WOUT) { r -= T_WIN; const int L = r / 8320, q = r % 8320; kt = q / 130; nt = q % 130; d.W = C.in[26] + (size_t)L * DM * NIN; d.ldw = NIN; d.nvalid = nt == 129 ? 32 : 64; d.gain = C.in[25] + L * DM; d.dst = (bf16_t*)(ws + WS_WINT) + (size_t)L * NINP * DM; d.drow0 = nt * 64; }
    else if (r < T_WC1) { r -= T_WOUT; const int L = r >> 12, q = r & 4095; kt = q >> 6; nt = q & 63; d.W = C.in[29] + (size_t)L * DM * DM; d.ldw = DM; d.dst = (bf16_t*)(ws + WS_WOUTT) + (size_t)L * DM * DM; d.drow0 = nt * 64; }
    else if (r < T_WC2) { r -= T_WC1; const int s = r >> 8, q = r & 255; kt = q >> 2; nt = q & 3; d.W = C.in[22] + (size_t)s * DM * 256; d.ldw = 256; d.dst = (bf16_t*)(ws + WS_WC1T) + (size_t)s * 256 * DM; d.drow0 = nt * 64; }
    else { r -= T_WC2; const int s = r >> 3, q = r & 7; kt = q >> 1; nt = q & 1; d.W = C.in[23] + (size_t)s * 256 * 128; d.ldw = 128; d.ldk = 256; d.dst = (bf16_t*)(ws + WS_WC2T) + (size_t)s * 128 * 256; d.drow0 = nt * 64; }
    d.k0 = kt * 64; d.n0 = nt * 64;
}
DI void convert_tasks(const Ctx& C, int lo0, int hi0, int lo1 = 0, int hi1 = 0, int lo2 = 0, int hi2 = 0, int lo3 = 0, int hi3 = 0) {
    const int gw = C.vcu * 8 + C.wave, NGW = C.G * 8, lane = C.lane; unsigned char* ws = C.ws;
#pragma unroll 1
    for (int k = 0; k < 4; ++k) { const int lo = k == 0 ? lo0 : k == 1 ? lo1 : k == 2 ? lo2 : lo3, hi = k == 0 ? hi0 : k == 1 ? hi1 : k == 2 ? hi2 : hi3;
    if (lo < T_CACHE) {
#pragma unroll 1
        for (int it = lo + gw; it < hi; it += NGW) { float va[64]; TrDesc da; tr_decode(C, it, da); tr_load(da, lane, va); tr_store(da, lane, va); }
        continue; }
#pragma unroll 1
    for (int it = lo + gw; it < hi; it += NGW) {
        int r = it;
        if (r < T_NORM) {
            r -= T_CACHE; const int* ptab = (const int*)C.in[7]; bf16_t* dst = (bf16_t*)(ws + WS_CMPS);
            f32x4 v[2][4]; int bb[2], pp[2];
#pragma unroll
            for (int rr = 0; rr < 2; ++rr) { const int row = r * 2 + rr, b = row >> 13, pos = row & 8191; bb[rr] = b; pp[rr] = pos;
                const float* src = C.in[2] + ((size_t)ptab[b * 64 + (pos >> 7)] * 128 + (pos & 127)) * 1024;
#pragma unroll
                for (int j = 0; j < 4; ++j) v[rr][j] = __builtin_nontemporal_load((const f32x4*)(src + j * 256 + lane * 4)); }
#pragma unroll
            for (int rr = 0; rr < 2; ++rr)
#pragma unroll
                for (int j = 0; j < 4; ++j) { const int pg = 2 * j + (lane >> 5), s = pg >> 2, g = pg & 3; u32x2 w; w.x = cvt_pk_bf16(v[rr][j][0], v[rr][j][1]); w.y = cvt_pk_bf16(v[rr][j][2], v[rr][j][3]);
                    *(u32x2*)(dst + (((size_t)(s * 32 + bb[rr] * 4 + g) * 8192 + pp[rr]) * 128) + (lane & 31) * 4) = w; }
            continue; }
        if (r < T_SP8) { r -= T_NORM; if (r < MP) norm_row(C.in[0] + (size_t)r * DM, (bf16_t*)(ws + WS_XB16) + (size_t)r * DM, C.sm + SM_RS + r, lane);
            else { const int b = r - MP; norm_row(C.in[1] + (size_t)b * DM, (bf16_t*)(C.sm + SM_XS16) + (size_t)b * DM, C.sm + SM_RS + MP + b, lane); } continue; }
        if (r < T_POSB) { r -= T_SP8; const int idx = r * 64 + lane; const float lam = C.in[16][idx]; const float sp = lam > 15.f ? __expf(-lam) : (lam < -15.f ? -lam : log1pf(__expf(-lam))); C.sm[SM_SP8 + idx] = -8.f * sp; C.sm[SM_ONES + idx] = 1.f; continue; }
        if (r < T_LUT) { r -= T_POSB; const int kc = r >> 3, s = (r >> 2) & 1, hq = r & 3, h = hq * 64 + lane; float acc = 0.f; const float* pos = C.in[21] + (size_t)s * DM; const float* w1 = C.in[22] + (size_t)s * DM * 256;
#pragma unroll 1
            for (int k = kc * 256; k < kc * 256 + 256; k += 16) { const float* wp = w1 + (size_t)k * 256 + h; float wv[16];
#pragma unroll
                for (int u = 0; u < 16; ++u) wv[u] = wp[u * 256];
                __builtin_amdgcn_sched_barrier(0);
#pragma unroll
                for (int u = 0; u < 16; ++u) acc += pos[k + u] * wv[u];
                __builtin_amdgcn_sched_barrier(0); }
            C.sm[SM_POSBP + (kc * 2 + s) * 256 + h] = acc; continue; }
        if (r < T_PAD) { r -= T_LUT; const int idx = r * 64 + lane; const int head = idx / 132, i = idx % 132; C.sm[SM_LUT + idx] = C.in[24][rel_bucket_dev(i < 128 ? i : 128) * 32 + head] * LOG2E; continue; }
        { r -= T_PAD; const int L = r / 160, row = NIN + r % 160; bf16_t* dp = (bf16_t*)(ws + WS_WINT) + ((size_t)L * NINP + row) * DM + lane * 64; const u32x4 z = {0u, 0u, 0u, 0u};
#pragma unroll
          for (int i = 0; i < 8; ++i) *(u32x4*)(dp + i * 8) = z; }
    } }
}
DI void conv_phase(const Ctx& C, int L) {
    const bf16_t* U = (const bf16_t*)(C.ws + WS_U); bf16_t* XC = (bf16_t*)(C.ws + WS_XC);
    const float* cw = C.in[10] + (size_t)L * 4 * DM; const float* cb = C.in[11] + (size_t)L * DM;
    const int c0 = C.tid * 8;
    float w[4][8], bia[8];
#pragma unroll
    for (int k = 0; k < 4; ++k) { const f32x4 a = *(const f32x4*)(cw + k * DM + c0), b = *(const f32x4*)(cw + k * DM + c0 + 4);
#pragma unroll
        for (int e = 0; e < 4; ++e) { w[k][e] = a[e]; w[k][4 + e] = b[e]; } }
    { const f32x4 a = *(const f32x4*)(cb + c0), b = *(const f32x4*)(cb + c0 + 4);
#pragma unroll
      for (int e = 0; e < 4; ++e) { bia[e] = a[e]; bia[4 + e] = b[e]; } }
    for (int u = C.vcu; u < 256; u += C.G) {
        const int b = u >> 6, t0 = (u & 63) * 32; const size_t r0 = (size_t)b * SEQ + t0;
        float x0[8], x1[8], x2[8];
        if (t0 == 0) {
#pragma unroll
            for (int e = 0; e < 8; ++e) { x0[e] = 0.f; x1[e] = 0.f; x2[e] = 0.f; } }
        else { unpack8(*(const u32x4*)(U + (r0 - 3) * 8192 + c0), x0); unpack8(*(const u32x4*)(U + (r0 - 2) * 8192 + c0), x1); unpack8(*(const u32x4*)(U + (r0 - 1) * 8192 + c0), x2); }
#pragma unroll 1
        for (int tb = 0; tb < 32; tb += 8) {
            u32x4 xw[8];
#pragma unroll
            for (int i = 0; i < 8; ++i) xw[i] = *(const u32x4*)(U + (r0 + tb + i) * 8192 + c0);
#pragma unroll
            for (int i = 0; i < 8; ++i) { float x3[8], o[8]; unpack8(xw[i], x3);
#pragma unroll
                for (int e = 0; e < 8; ++e) { o[e] = bia[e] + w[0][e] * x0[e] + w[1][e] * x1[e] + w[2][e] * x2[e] + w[3][e] * x3[e]; x0[e] = x1[e]; x1[e] = x2[e]; x2[e] = x3[e]; }
                *(u32x4*)(XC + (r0 + tb + i) * DM + c0) = pack8f(o); }
        }
        if (t0 == SEQ - 32) { float* pc = C.out + O_PCONV + ((size_t)(L * NBATCH + b) * 3) * DM + c0;
#pragma unroll
            for (int e = 0; e < 8; ++e) { pc[e] = x0[e]; pc[DM + e] = x1[e]; pc[2 * DM + e] = x2[e]; } }
    }
}
template <int PASS>
DI void scan_phase(const Ctx& C, int L) {
    const bf16_t* LA = (const bf16_t*)(C.ws + WS_LA); const bf16_t* BIN = (const bf16_t*)(C.ws + WS_BIN); const bf16_t* U = (const bf16_t*)(C.ws + WS_U);
    bf16_t* HG = (bf16_t*)(C.ws + WS_HG); float* AGA = (float*)(C.ws + WS_AGG); float* AGH = AGA + 4 * 16 * DM;
    for (int u = C.vcu; u < 256; u += C.G) {
        const int b = u >> 6, ch = (u >> 2) & 15, slab = u & 3, c0 = slab * 1024 + C.tid * 2; const size_t r0 = (size_t)b * SEQ + ch * 128;
        float h0 = 0.f, h1 = 0.f, s0 = 0.f, s1 = 0.f;
        if (PASS == 3) { for (int j = 0; j < ch; ++j) { const f32x2 a = *(const f32x2*)(AGA + (size_t)(b * 16 + j) * DM + c0), hh = *(const f32x2*)(AGH + (size_t)(b * 16 + j) * DM + c0); h0 = a[0] * h0 + hh[0]; h1 = a[1] * h1 + hh[1]; } }
#pragma unroll 1
        for (int tb = 0; tb < 128; tb += 16) {
            unsigned lw[16], bw[16], gw[16];
#pragma unroll
            for (int i = 0; i < 16; ++i) { lw[i] = *(const unsigned*)(LA + (r0 + tb + i) * DM + c0); bw[i] = *(const unsigned*)(BIN + (r0 + tb + i) * DM + c0);
                if (PASS == 3) gw[i] = *(const unsigned*)(U + (r0 + tb + i) * 8192 + DM + c0); }
#pragma unroll
            for (int i = 0; i < 16; ++i) { const float l0 = lo_bf(lw[i]), l1 = hi_bf(lw[i]);
                h0 = __builtin_amdgcn_exp2f(l0 * LOG2E) * h0 + lo_bf(bw[i]); h1 = __builtin_amdgcn_exp2f(l1 * LOG2E) * h1 + hi_bf(bw[i]);
                if (PASS == 1) { s0 += l0; s1 += l1; }
                else { *(unsigned*)(HG + (r0 + tb + i) * DM + c0) = cvt_pk_bf16(h0 * siluf_(lo_bf(gw[i])), h1 * siluf_(hi_bf(gw[i]))); } }
        }
        if (PASS == 1) { *(f32x2*)(AGA + (size_t)(b * 16 + ch) * DM + c0) = (f32x2){__expf(s0), __expf(s1)}; *(f32x2*)(AGH + (size_t)(b * 16 + ch) * DM + c0) = (f32x2){h0, h1}; }
        else if (ch == 15) { *(f32x2*)(C.out + O_PLRU + (size_t)(L * NBATCH + b) * DM + c0) = (f32x2){h0, h1}; }
    }
}
DI void rs_phase(const Ctx& C, const float* part, const float* xs) {
    LAS float* red = (LAS float*)C.lds;
    const int rl = C.tid & 31, q = C.tid >> 5;
    for (int r0 = C.vcu * 32; r0 < MP; r0 += C.G * 32) {
        const float* pp = part + (size_t)(q * 4) * MP + r0 + rl;
        const float a0 = pp[0], a1 = pp[MP], a2 = pp[2 * MP], a3 = pp[3 * MP];
        red[q * 32 + rl] = (a0 + a1) + (a2 + a3);
        __syncthreads();
        if (C.tid < 32) { float t = 0.f;
#pragma unroll
            for (int k = 0; k < 16; ++k) t += red[k * 32 + C.tid];
            C.sm[SM_RS + r0 + C.tid] = frsq(t * (1.f / DM) + EPS); }
        __syncthreads();
    }
    const int gw = C.vcu * 8 + C.wave, NGW = C.G * 8;
    for (int b = gw; b < NSMP; b += NGW) norm_row(xs + (size_t)b * DM, (bf16_t*)(C.sm + SM_XS16) + (size_t)b * DM, C.sm + SM_RS + MP + b, C.lane);
}
DI void kvpost_phase(const Ctx& C) {
    const int gw = C.vcu * 8 + C.wave, NGW = C.G * 8, lane = C.lane; const float* knorm = C.in[20];
    const int pgl = lane >> 5, d0 = (lane & 31) * 4;
    for (int r = gw; r < MP; r += NGW) {
        const int b = r >> 11, t = r & 2047;
#pragma unroll
        for (int part = 0; part < 3; ++part) {
            const float* src = part == 0 ? C.out + O_PCMP + (size_t)r * 1024 : (part == 1 ? C.out + O_PSLC + (size_t)r * 1024 : (const float*)(C.ws + WS_WINRAW) + (size_t)r * 1024);
            f32x4 v[4];
#pragma unroll
            for (int j = 0; j < 4; ++j) v[j] = *(const f32x4*)(src + j * 256 + lane * 4);
            if (part == 2 && t >= SEQ - 512) { float* pw = C.out + O_PWIN + ((size_t)b * 512 + (t - (SEQ - 512))) * 1024;
#pragma unroll
                for (int j = 0; j < 4; ++j) *(f32x4*)(pw + j * 256 + lane * 4) = v[j]; }
#pragma unroll
            for (int j = 0; j < 4; ++j) { const int pg = 2 * j + pgl, s = pg >> 2, g = pg & 3; f32x4 x = v[j];
                if (part > 0 && s == 0) { float ss = x[0] * x[0] + x[1] * x[1] + x[2] * x[2] + x[3] * x[3];
                    ss = sum32(ss);
                    const float sc = frsq(ss * (1.f / HD) + EPS); const f32x4 kn = *(const f32x4*)(knorm + part * HD + d0); x = x * sc * kn; }
                u32x2 w; w.x = cvt_pk_bf16(x[0], x[1]); w.y = cvt_pk_bf16(x[2], x[3]);
                bf16_t* dst;
                if (part == 0) dst = (bf16_t*)(C.ws + WS_CMPP) + ((size_t)(s * 16 + b * 4 + g) * SEQ + t) * HD + d0;
                else dst = (bf16_t*)(C.ws + (part == 1 ? (s ? WS_SLCV : WS_SLCK) : (s ? WS_WINV : WS_WINK))) + ((size_t)(b * 4 + g) * SEQ + t) * HD + d0;
                *(u32x2*)dst = w; }
        }
    }
    const float* kvs = C.sm + SM_KVS;
    for (int i = C.vcu * 512 + C.tid; i < NSMP * 2048; i += C.G * 512) { const int b = i >> 11, c = i & 2047; C.out[(c < 1024 ? O_SCMP : O_SSLC - 1024) + (size_t)b * 1024 + c] = kvs[b * 3072 + c]; }
    for (size_t i = (size_t)C.vcu * 512 + C.tid; i < (size_t)NSMP * 512 * 256; i += (size_t)C.G * 512) {
        const int b = (int)(i >> 17), rem = (int)(i & 131071), row = rem >> 8, c4 = rem & 255;
        const f32x4 v = row < 511 ? *(const f32x4*)(C.in[4] + ((size_t)b * 512 + row + 1) * 1024 + c4 * 4) : *(const f32x4*)(kvs + b * 3072 + 2048 + c4 * 4);
        *(f32x4*)(C.out + O_SWIN + ((size_t)b * 512 + row) * 1024 + c4 * 4) = v; }
}
DI void cmp2_phase(const Ctx& C) {
    const int gw = C.vcu * 8 + C.wave, NGW = C.G * 8, lane = C.lane, i = lane & 15, kq = lane >> 4;
    const bf16_t* W2 = (const bf16_t*)(C.ws + WS_WC2T); const bf16_t* HS = (const bf16_t*)(C.ws + WS_HIDS); const float* HP = (const float*)(C.ws + WS_LA);
    const float* posb = C.sm + SM_POSB; const float* kn0 = C.in[20];
    constexpr int NT_S = 32768 / 16, NT_P = 4096 / 16;
    LAS bf16_t* hidt = (LAS bf16_t*)C.lds;
    const int n_s = (NT_S - gw + NGW - 1) / NGW, n_pw = (NT_P - C.vcu + C.G - 1) / C.G, n_p = C.wave == 0 ? n_pw : 0;
    for (int it = 0; it < n_pw + n_s; ++it) {
        const bool prm = it < n_pw; const int m0 = (prm ? C.vcu + it * C.G : gw + (it - n_pw) * NGW) * 16;
        const int s = prm ? (m0 >> 11) : (m0 >> 14);
        if (prm) { const int row = C.tid >> 5, c8 = (C.tid & 31) * 8; f32x4 s0 = *(const f32x4*)(posb + s * 256 + c8), s1 = *(const f32x4*)(posb + s * 256 + c8 + 4);
            f32x4 pv0[8], pv1[8];
#pragma unroll
            for (int ks = 0; ks < 8; ++ks) { const float* p = HP + ((size_t)ks * 4096 + m0 + row) * 256 + c8; pv0[ks] = *(const f32x4*)p; pv1[ks] = *(const f32x4*)(p + 4); }
            __builtin_amdgcn_sched_barrier(0);
#pragma unroll
            for (int ks = 0; ks < 8; ++ks) { s0 += pv0[ks]; s1 += pv1[ks]; }
            float v[8];
#pragma unroll
            for (int e = 0; e < 4; ++e) { v[e] = siluf_(s0[e]); v[4 + e] = siluf_(s1[e]); }
            __syncthreads();
            *(LAS u32x4*)(hidt + row * 256 + c8) = pack8f(v);
            __syncthreads();
            if (C.wave != 0) continue; }
        bf16x8 a[8];
        if (!prm) {
#pragma unroll
            for (int st = 0; st < 8; ++st) a[st] = *(const bf16x8*)(HS + (size_t)(m0 + i) * 256 + st * 32 + kq * 8); }
        else {
#pragma unroll
            for (int st = 0; st < 8; ++st) a[st] = *(LAS const bf16x8*)(hidt + i * 256 + st * 32 + kq * 8); }
        f32x4 acc[8];
        bf16x8 bq[2][8];
#pragma unroll
        for (int st = 0; st < 8; ++st) bq[0][st] = *(const bf16x8*)(W2 + ((size_t)s * 128 + i) * 256 + st * 32 + kq * 8);
#pragma unroll
        for (int nt = 0; nt < 8; ++nt) { acc[nt] = (f32x4){0.f, 0.f, 0.f, 0.f};
            if (nt < 7) {
#pragma unroll
                for (int st = 0; st < 8; ++st) bq[(nt + 1) & 1][st] = *(const bf16x8*)(W2 + ((size_t)s * 128 + (nt + 1) * 16 + i) * 256 + st * 32 + kq * 8); }
            __builtin_amdgcn_sched_barrier(0);
#pragma unroll
            for (int st = 0; st < 8; ++st) acc[nt] = __builtin_amdgcn_mfma_f32_16x16x32_bf16(a[st], bq[nt & 1][st], acc[nt], 0, 0, 0);
            __builtin_amdgcn_sched_barrier(0); }
        float sc[4] = {1.f, 1.f, 1.f, 1.f};
        if (s == 0) {
#pragma unroll
            for (int v = 0; v < 4; ++v) { float ss = 0.f;
#pragma unroll
                for (int nt = 0; nt < 8; ++nt) ss += acc[nt][v] * acc[nt][v];
                ss = sum16(ss);
                sc[v] = frsq(ss * (1.f / HD) + EPS); } }
        bf16_t* dstv[4]; bool okv[4];
#pragma unroll
        for (int v = 0; v < 4; ++v) { const int m = m0 + kq * 4 + v; int slab, n;
            if (!prm) { slab = (m >> 9) & 31; n = m & 511; okv[v] = n < 511; dstv[v] = (bf16_t*)(C.ws + (s ? WS_VCS : WS_KCS)) + ((size_t)slab * 512 + n) * HD; }
            else { slab = (m >> 7) & 15; n = m & 127; okv[v] = n < 127; dstv[v] = (bf16_t*)(C.ws + (s ? WS_VCP : WS_KCP)) + ((size_t)slab * 128 + n) * HD; } }
#pragma unroll
        for (int nt = 0; nt < 8; ++nt) { const int col = nt * 16 + i; const float kn = s == 0 ? kn0[col] : 1.f;
#pragma unroll
            for (int v = 0; v < 4; ++v) { float x = acc[nt][v] * sc[v] * kn; if (!okv[v]) x = 0.f;
                dstv[v][col] = (bf16_t)(cvt_pk_bf16(x, 0.f) & 0xffffu); } }
    }
}
DI void sample_conv(const Ctx& C, int L) {
    const float* cw = C.in[10] + (size_t)L * 4 * DM; const float* cb = C.in[11] + (size_t)L * DM; const float* st = C.in[6] + (size_t)L * NSMP * 3 * DM; const float* us = C.sm + SM_US;
    for (int idx = C.vcu * 512 + C.tid; idx < NSMP * DM; idx += C.G * 512) { const int b = idx >> 12, c = idx & 4095;
        const float s0 = st[(size_t)(b * 3 + 0) * DM + c], s1 = st[(size_t)(b * 3 + 1) * DM + c], s2 = st[(size_t)(b * 3 + 2) * DM + c], xb = us[b * 8448 + c];
        const float xc = cb[c] + cw[c] * s0 + cw[DM + c] * s1 + cw[2 * DM + c] * s2 + cw[3 * DM + c] * xb;
        C.sm[SM_XCS + idx] = xc; ((bf16_t*)(C.sm + SM_XCS16))[idx] = (bf16_t)(cvt_pk_bf16(xc, 0.f) & 0xffffu);
        float* sc = C.out + O_SCONV + ((size_t)(L * NSMP + b) * 3) * DM + c; sc[0] = s1; sc[DM] = s2; sc[2 * DM] = xb; }
}
DI void sample_scan(const Ctx& C, int L) {
    const float* gs = C.sm + SM_GS; const float* us = C.sm + SM_US; const float* brg = C.in[13] + (size_t)L * DM; const float* big = C.in[15] + (size_t)L * DM; const float* sp8 = C.sm + SM_SP8 + L * DM;
    const float* h0p = C.in[5] + (size_t)L * NSMP * DM;
    for (int idx = C.vcu * 512 + C.tid; idx < NSMP * DM; idx += C.G * 512) { const int b = idx >> 12, c = idx & 4095;
        const int colr = ((c >> 8) * 2 + ((c >> 7) & 1)) * 256 + (c & 127);
        const float r = sigmoidf_(gs[b * 8192 + colr] + brg[c]), ig = sigmoidf_(gs[b * 8192 + colr + 128] + big[c]);
        const float la = sp8[c] * r, a = fexp(la), mult = fsqrt(fmaxf(1.f - fexp(2.f * la), 0.f));
        const float h = a * h0p[idx] + mult * ig * C.sm[SM_XCS + idx];
        C.out[O_SLRU + (size_t)L * NSMP * DM + idx] = h;
        ((bf16_t*)(C.sm + SM_HGS16))[idx] = (bf16_t)(cvt_pk_bf16(h * siluf_(us[b * 8448 + DM + c]), 0.f) & 0xffffu); }
}

namespace satt {
constexpr int QS_OFF = 0, LG_OFF = 4096, LG_STRIDE = 1088, KT_OFF = LG_OFF + 8 * LG_STRIDE * 4, VT_OFF = KT_OFF + 64 * 132 * 4, IMP_OFF = VT_OFF + 64 * 128 * 4, LIST_OFF = IMP_OFF + 132 * 4, SEL_OFF = LIST_OFF + 64, S_END = SEL_OFF + 132 * 4;
static_assert(S_END <= LDS_MAIN, "sample attention LDS");
struct Src { const float* cslc; const float* swin; const int* ptab; const float* kvs; const bf16_t* kcs; const bf16_t* vcs; const float* knorm; };
DI void stage_load(const Ctx& C, const Src& S, int kind, int tile, bool is_v, int b, int g, f32x4 (&v)[4]) {
    LAS const int* list = (LAS const int*)(C.lds + LIST_OFF);
    const int sv = is_v ? 1 : 0, slab = b * 4 + g;
#pragma unroll
    for (int i = 0; i < 4; ++i) { const int idx = C.tid + 512 * i, key = idx >> 5, c4 = idx & 31, slot = tile * 64 + key; v[i] = (f32x4){0.f, 0.f, 0.f, 0.f};
        if (kind == 0) { if (slot < 511) { const u32x2 w = *(const u32x2*)((is_v ? S.vcs : S.kcs) + ((size_t)slab * 512 + slot) * HD + c4 * 4); v[i] = (f32x4){lo_bf(w.x), hi_bf(w.x), lo_bf(w.y), hi_bf(w.y)}; } }
        else { const float* p = nullptr;
            if (kind == 1) { const int kpos = list[slot >> 6] * 64 + (slot & 63);
                if (kpos == PAST) p = S.kvs + b * 3072 + 1024 + sv * 512 + g * HD; else if (kpos < PAST) p = S.cslc + (((size_t)S.ptab[b * 64 + (kpos >> 7)] * 128 + (kpos & 127)) * 2 + sv) * 512 + g * HD; }
            else { if (slot < 512) p = S.swin + (((size_t)b * 512 + slot) * 2 + sv) * 512 + g * HD; else if (slot == 512) p = S.kvs + b * 3072 + 2048 + sv * 512 + g * HD; }
            if (p) v[i] = *(const f32x4*)(p + c4 * 4); } }
}
DI void stage_store(const Ctx& C, const Src& S, int kind, bool is_v, f32x4 (&v)[4]) {
    LAS float* Kt = (LAS float*)(C.lds + KT_OFF); LAS float* Vt = (LAS float*)(C.lds + VT_OFF);
#pragma unroll
    for (int i = 0; i < 4; ++i) { const int idx = C.tid + 512 * i, key = idx >> 5, c4 = idx & 31; f32x4 x = v[i];
        if (kind != 0 && !is_v) { float ss = x[0] * x[0] + x[1] * x[1] + x[2] * x[2] + x[3] * x[3];
            ss = sum32(ss);
            const float sc = frsq(ss * (1.f / HD) + EPS); const f32x4 kn = *(const f32x4*)(S.knorm + kind * HD + c4 * 4); x = x * sc * kn; }
        if (is_v) *(LAS f32x4*)(Vt + key * 128 + c4 * 4) = x; else *(LAS f32x4*)(Kt + key * 132 + c4 * 4) = x; }
}
DI bool slot_info(const Ctx& C, int kind, int slot, int& d) {
    LAS const int* list = (LAS const int*)(C.lds + LIST_OFF);
    if (kind == 0) { d = PAST - (16 * slot + 31); return slot < 511; }
    if (kind == 1) { const int kpos = list[slot >> 6] * 64 + (slot & 63); d = PAST - kpos; return kpos <= PAST; }
    d = 512 - slot; return slot <= 512;
}
DI void logits_softmax(const Ctx& C, const Src& S, int kind, int ntiles, int b, int g, const float* lutG) {
    LAS float* lg = (LAS float*)(C.lds + LG_OFF) + C.wave * LG_STRIDE; LAS const float* qs = (LAS const float*)(C.lds + QS_OFF) + C.wave * 128; LAS const float* Kt = (LAS const float*)(C.lds + KT_OFF);
    const float* lut = lutG + (g * 8 + C.wave) * 132;
    f32x4 sa_[4], sb_[4]; stage_load(C, S, kind, 0, false, b, g, sa_); if (ntiles > 1) stage_load(C, S, kind, 1, false, b, g, sb_);
#define SATT_LOGIT_STEP(T_, CUR, NXT) do { \
        stage_store(C, S, kind, false, CUR); \
        __syncthreads(); \
        if ((T_) + 2 < ntiles) stage_load(C, S, kind, (T_) + 2, false, b, g, CUR); \
        float dot = 0.f; \
        _Pragma("unroll 8") for (int d4 = 0; d4 < 32; ++d4) { const f32x4 kv = *(LAS const f32x4*)(Kt + C.lane * 132 + d4 * 4), qv = *(LAS const f32x4*)(qs + d4 * 4); dot += kv[0] * qv[0] + kv[1] * qv[1] + kv[2] * qv[2] + kv[3] * qv[3]; } \
        int d; const bool ok = slot_info(C, kind, (T_) * 64 + C.lane, d); \
        lg[(T_) * 64 + C.lane] = ok ? dot + lut[d < 128 ? (d > 0 ? d : 0) : 128] * 0.6931471805599453f : -__builtin_inff(); \
        __syncthreads(); } while (0)
    for (int t = 0; t < ntiles; t += 2) { SATT_LOGIT_STEP(t, sa_, sb_); if (t + 1 < ntiles) SATT_LOGIT_STEP(t + 1, sb_, sa_); }
#undef SATT_LOGIT_STEP
    float m = -1e30f;
    for (int t = 0; t < ntiles; ++t) m = fmaxf(m, lg[t * 64 + C.lane]);
    m = wave_max(m);
    float s = 0.f;
    for (int t = 0; t < ntiles; ++t) { const float e = __expf(lg[t * 64 + C.lane] - m); lg[t * 64 + C.lane] = e; s += e; }
    s = wave_sum(s); const float inv = s > 0.f ? frcp(s) : 0.f;
    for (int t = 0; t < ntiles; ++t) lg[t * 64 + C.lane] *= inv;
    __syncthreads();
}
DI void pv(const Ctx& C, const Src& S, int kind, int ntiles, int b, int g, float w, float& o0, float& o1) {
    LAS const float* lg = (LAS const float*)(C.lds + LG_OFF) + C.wave * LG_STRIDE; LAS const float* Vt = (LAS const float*)(C.lds + VT_OFF);
    float a0 = 0.f, a1 = 0.f;
    f32x4 sa_[4], sb_[4]; stage_load(C, S, kind, 0, true, b, g, sa_); if (ntiles > 1) stage_load(C, S, kind, 1, true, b, g, sb_);
#define SATT_PV_STEP(T_, CUR) do { \
        stage_store(C, S, kind, true, CUR); \
        __syncthreads(); \
        if ((T_) + 2 < ntiles) stage_load(C, S, kind, (T_) + 2, true, b, g, CUR); \
        _Pragma("unroll 8") for (int k = 0; k < 64; ++k) { const float p = lg[(T_) * 64 + k]; a0 += p * Vt[k * 128 + C.lane]; a1 += p * Vt[k * 128 + 64 + C.lane]; } \
        __syncthreads(); } while (0)
    for (int t = 0; t < ntiles; t += 2) { SATT_PV_STEP(t, sa_); if (t + 1 < ntiles) SATT_PV_STEP(t + 1, sb_); }
#undef SATT_PV_STEP
    o0 += w * a0; o1 += w * a1;
}
DI void unit(const Ctx& C, const Src& S, int b, int g, const float* us, const float* qnorm, const float* gate_bias, const float* lutG, bf16_t* aos) {
    const int head = g * 8 + C.wave, lane = C.lane;
    LAS float* qs = (LAS float*)(C.lds + QS_OFF) + C.wave * 128;
    { const float q0 = us[b * 8448 + head * HD + lane], q1 = us[b * 8448 + head * HD + 64 + lane]; const float ss = wave_sum(q0 * q0 + q1 * q1);
      const float sc = frsq(ss * (1.f / HD) + EPS) * 0.08838834764831845f; qs[lane] = q0 * sc * qnorm[lane]; qs[64 + lane] = q1 * sc * qnorm[64 + lane]; }
    float bg[3];
#pragma unroll
    for (int k = 0; k < 3; ++k) bg[k] = sigmoidf_(us[b * 8448 + 8192 + head * 3 + k] + gate_bias[head * 3 + k]);
    __syncthreads();
    float o0 = 0.f, o1 = 0.f;
    logits_softmax(C, S, 0, 8, b, g, lutG);
    {
        LAS float* imp = (LAS float*)(C.lds + IMP_OFF); LAS int* sel = (LAS int*)(C.lds + SEL_OFF); LAS int* list = (LAS int*)(C.lds + LIST_OFF);
        if (C.tid < 129) { const int j = C.tid; float v = 0.f;
            for (int w = 0; w < 8; ++w) { LAS const float* pc = (LAS const float*)(C.lds + LG_OFF) + w * LG_STRIDE;
#pragma unroll
                for (int k = -1; k <= 3; ++k) { const int n = 4 * j + k; if (n >= 0 && n < 511) v += ((k == -1 || k == 3) ? 0.5f : 1.f) * pc[n]; } }
            imp[j] = v; }
        __syncthreads();
        if (C.tid < 129) { const int j = C.tid; int s_ = 0;
            if (j == 0 || j >= 127) s_ = 1;
            else { const float v = imp[j]; int rank = 0; for (int k = 1; k < 127; ++k) { const float vk = imp[k]; rank += (vk > v || (vk == v && k < j)) ? 1 : 0; } s_ = rank < 13; }
            sel[j] = s_; }
        __syncthreads();
        if (C.tid == 0) { int n = 0; for (int j = 0; j < 129 && n < 16; ++j) if (sel[j]) list[n++] = j; for (; n < 16; ++n) list[n] = 200; }
    }
    pv(C, S, 0, 8, b, g, bg[0], o0, o1);
    logits_softmax(C, S, 1, 16, b, g, lutG);
    pv(C, S, 1, 16, b, g, bg[1], o0, o1);
    logits_softmax(C, S, 2, 9, b, g, lutG);
    pv(C, S, 2, 9, b, g, bg[2], o0, o1);
    const float g0 = us[b * 8448 + DM + head * HD + lane], g1 = us[b * 8448 + DM + head * HD + 64 + lane];
    aos[b * DM + head * HD + lane] = (bf16_t)(cvt_pk_bf16(o0 * siluf_(g0), 0.f) & 0xffffu);
    aos[b * DM + head * HD + 64 + lane] = (bf16_t)(cvt_pk_bf16(o1 * siluf_(g1), 0.f) & 0xffffu);
    __syncthreads();
}
}

__global__ void __launch_bounds__(512, 2) fwd(Args args) {
    extern __shared__ __attribute__((aligned(16))) unsigned char lds_raw[];
    Ctx C; C.lds = (LAS unsigned char*)lds_raw; C.in = args.in; C.out = args.out; C.ws = args.ws; C.sm = (float*)(args.ws + WS_SMALL);
    C.tid = threadIdx.x; C.lane = C.tid & 63; C.wave = __builtin_amdgcn_readfirstlane(C.tid >> 6); C.G = gridDim.x;
    { const int bx = blockIdx.x; C.vcu = (C.G % 8 == 0) ? (bx % 8) * (C.G / 8) + bx / 8 : bx; }
    const int bid = blockIdx.x;
    volatile LAS unsigned* MISC = (volatile LAS unsigned*)(C.lds + LDS_MISC);
    if (C.tid < 64) MISC[C.tid] = 0u;
    if (C.lane == 0) ((volatile LAS int*)(C.lds + LDS_WTAB))[hw_wave_key()] = C.tid >> 6;
    __syncthreads();
    const int lo = args.ph_lo, hi = args.ph_hi;
    XcdBarrier bar; bar.bar = (unsigned*)(C.ws + WS_CTL) + CW_BAR; bar.x = 0; bar.st = MISC + 8;
    if (hi - lo > 1) bar = xcd_barrier_post((unsigned*)(C.ws + WS_CTL) + CW_BAR, MISC + 8);
#ifndef PMASK
#define PMASK 0xffffffffu
#endif
#define EN(b) ((PMASK >> (b)) & 1u)
#define IN(k) (lo <= (k) && (k) < hi)
#define SEAM(k) do { if (IN(k) && IN((k) + 1)) xcd_barrier(bar); } while (0)
    unsigned char* ws = C.ws; float* sm = C.sm; const float* rs = sm + SM_RS;
#define XB16 ((bf16_t*)(ws + WS_XB16))
#define XS16 ((bf16_t*)(sm + SM_XS16))
#define XA ((float*)(ws + WS_XA))
#define XBF ((float*)(ws + WS_XBF))
#define XSA (sm + SM_XS)
#define XSB (sm + SM_XS + 32768)

    if (IN(0) && EN(0)) { convert_tasks(reopaque(C), T_W1T, T_W1T + 8192, T_NORM, T_POSB, T_LUT, T_PAD); } SEAM(0);

#pragma unroll 1
    for (int L = 0; L < 2; ++L) {
        const int pb = 1 + 7 * L;
        { size_t z_ = 0; asm volatile("" : "+s"(z_)); ws += z_; sm = (float*)((unsigned char*)sm + z_); rs = (const float*)((const unsigned char*)rs + z_); }
        int bid = blockIdx.x; asm volatile("" : "+s"(bid));
        const float* xsin = L == 0 ? C.in[1] : XSA; float* xsout = L == 0 ? XSA : XSB;
        if (IN(pb + 0) && EN(1)) {
            pg8::Gemm g{XB16, (const bf16_t*)(ws + WS_W1T) + (size_t)L * 8192 * DM, DM, DM, DM, 0}; pg8::StaticOrder S; S.init(MP, 8192, C.G, bid);
            if (L == 1) { g.wctr = (unsigned*)(ws + WS_CTL) + CW_SPLIT; g.wtarget = (unsigned)C.G; g.wst = MISC + 8; }
            pg8::EpiBf16Rs E{(bf16_t*)(ws + WS_U), (bf16_t*)(ws + WS_U), 8192, rs, 1 << 20};
            const bool cf = bid & 1;
            if (cf) { if (L == 0) convert_tasks(reopaque(C), T_WGT, T_WGT + 512, T_W2T, T_W2T + 4096, T_W1T + 8192, T_W1T + 16384, T_POSB, T_LUT); else convert_tasks(reopaque(C), T_CACHE, T_NORM); }
            pg8::gemm_phase(C.lds, g, S, E);
            if (!cf) { if (L == 0) convert_tasks(reopaque(C), T_WGT, T_WGT + 512, T_W2T, T_W2T + 4096, T_W1T + 8192, T_W1T + 16384, T_POSB, T_LUT); else convert_tasks(reopaque(C), T_CACHE, T_NORM); }
            float* us = sm + SM_US; const float* rss = rs + MP;
            skinny_gemm(reopaque(C), XS16, DM, (const bf16_t*)(ws + WS_W1T) + (size_t)L * 8192 * DM, DM, 8192, DM, 0, [=](int row, int col, float v) { us[row * 8448 + col] = v * rss[row]; });
        } SEAM(pb + 0);
        if (IN(pb + 1) && EN(2)) {
            if (L == 0 && bid == 0) { float s_ = 0.f; int t_ = tid_now(C.lds); asm volatile("" : "+v"(t_));
                float pv_[16];
#pragma unroll
                for (int kc = 0; kc < 16; ++kc) pv_[kc] = sm[SM_POSBP + kc * 512 + t_];
                __builtin_amdgcn_sched_barrier(0);
#pragma unroll
                for (int kc = 0; kc < 16; ++kc) s_ += pv_[kc];
                sm[SM_POSB + t_] = s_; }
            conv_phase(reopaque(C), L); sample_conv(reopaque(C), L); } SEAM(pb + 1);
        if (IN(pb + 2) && EN(3)) {
            pg8::Gemm g{(const bf16_t*)(ws + WS_XC), (const bf16_t*)(ws + WS_WGT) + (size_t)L * 8192 * 256, DM, 256, 256, 1}; pg8::StaticOrder S; S.init(MP, 8192, C.G, bid);
            pg8::EpiGate E{(const bf16_t*)(ws + WS_XC), (bf16_t*)(ws + WS_LA), (bf16_t*)(ws + WS_BIN), C.in[13] + (size_t)L * DM, C.in[15] + (size_t)L * DM, sm + SM_SP8 + L * DM};
            pg8::gemm_phase(C.lds, g, S, E);
            float* gs = sm + SM_GS;
            skinny_gemm(reopaque(C), (const bf16_t*)(sm + SM_XCS16), DM, (const bf16_t*)(ws + WS_WGT) + (size_t)L * 8192 * 256, 256, 8192, 256, 1, [=](int row, int col, float v) { gs[row * 8192 + col] = v; });
        } SEAM(pb + 2);
        if (IN(pb + 3) && EN(4)) { scan_phase<1>(reopaque(C), L); sample_scan(reopaque(C), L); } SEAM(pb + 3);
        if (IN(pb + 4) && EN(5)) { scan_phase<3>(reopaque(C), L); } SEAM(pb + 4);
        if (IN(pb + 5) && EN(6)) {
            pg8::Gemm g{(const bf16_t*)(ws + WS_HG), (const bf16_t*)(ws + WS_W2T) + (size_t)L * DM * DM, DM, DM, DM, 0}; pg8::StaticOrder S; S.init(MP, DM, C.G, bid);
            pg8::EpiXRes<false> E{XB16, nullptr, (float*)(ws + WS_YB)};
            const bool cf = bid & 1;
            if (cf) { if (L == 0) convert_tasks(reopaque(C), T_WGT + 512, T_WGT + 1024, T_W2T + 4096, T_W2T + 8192, T_WKV, T_WIN, T_WC1, T_CACHE); else convert_tasks(reopaque(C), T_WIN, T_WIN + 8320, T_PAD, T_END); }
            pg8::gemm_phase(C.lds, g, S, E);
            if (!cf) { if (L == 0) convert_tasks(reopaque(C), T_WGT + 512, T_WGT + 1024, T_W2T + 4096, T_W2T + 8192, T_WKV, T_WIN, T_WC1, T_CACHE); else convert_tasks(reopaque(C), T_WIN, T_WIN + 8320, T_PAD, T_END); }
            skinny_gemm<1>(reopaque(C), (const bf16_t*)(sm + SM_HGS16), DM, (const bf16_t*)(ws + WS_W2T) + (size_t)L * DM * DM, DM, DM, DM, 0, [=](int row, int col, float v) { xsout[row * DM + col] = xsin[row * DM + col] + v; });
        } SEAM(pb + 5);
        if (IN(pb + 6) && EN(7)) { rs_phase(reopaque(C), (const float*)(ws + WS_YB), xsout); split_arrive((unsigned*)(ws + WS_CTL) + CW_SPLIT + L * 16, MISC + 8); }
    }

    if (IN(15) && EN(8)) {
        { pg8::Gemm g{XB16, (const bf16_t*)(ws + WS_WKVT), DM, DM, DM, 0}; pg8::StaticOrder S; S.init(MP, 3072, C.G, bid);
          g.wctr = (unsigned*)(ws + WS_CTL) + CW_SPLIT + 16; g.wtarget = (unsigned)C.G; g.wst = MISC + 8;
          pg8::EpiKV E{C.out + O_PCMP, C.out + O_PSLC, (float*)(ws + WS_WINRAW), rs};
          const bool cf = blockIdx.x & 1;
          if (cf) convert_tasks(reopaque(C), T_WOUT, T_WOUT + 4096);
          pg8::gemm_phase(C.lds, g, S, E);
          if (!cf) convert_tasks(reopaque(C), T_WOUT, T_WOUT + 4096); }
        { pg8::Gemm g{(const bf16_t*)(ws + WS_CMPS), (const bf16_t*)(ws + WS_WC1T), 2048, DM, DM, 0}; pg8::ListOrder S{128, C.G, (bid + C.G / 2) % C.G, 0, 0, 0};
          pg8::EpiHidS E{(bf16_t*)(ws + WS_HIDS), sm + SM_POSB};
          pg8::gemm_phase(C.lds, g, S, E); }
        float* kvs = sm + SM_KVS; const float* rss = rs + MP;
        skinny_gemm<1>(reopaque(C), XS16, DM, (const bf16_t*)(ws + WS_WKVT), DM, 3072, DM, 0, [=](int row, int col, float v) { kvs[row * 3072 + col] = v * rss[row]; });
    } SEAM(15);
    if (IN(16) && EN(9)) { kvpost_phase(reopaque(C)); } SEAM(16);

#pragma unroll 1
    for (int li = 0; li < 2; ++li) {
        { size_t z_ = 0; asm volatile("" : "+s"(z_)); ws += z_; sm = (float*)((unsigned char*)sm + z_); rs = (const float*)((const unsigned char*)rs + z_); }
        int bid = blockIdx.x; asm volatile("" : "+s"(bid));
        const int pb = li == 0 ? 17 : 22, p_att = li == 0 ? 19 : 23, p_out = li == 0 ? 20 : 24;
        const float* xsin = li == 0 ? XSB : XSA; float* xsout = li == 0 ? XSA : C.out + O_YS;
        const bf16_t* WIN = (const bf16_t*)(ws + WS_WINT) + (size_t)li * NINP * DM;
        if (IN(pb) && EN(10)) {
            { pg8::Gemm g{XB16, WIN, DM, DM, DM, 0}; pg8::StaticOrder S; S.init(MP, 8192, C.G, bid);
              if (li == 1) { g.wctr = (unsigned*)(ws + WS_CTL) + CW_SPLIT + 2 * 16; g.wtarget = (unsigned)C.G; g.wst = MISC + 8; }
              pg8::EpiBf16Rs E{(bf16_t*)(ws + WS_U), (bf16_t*)(ws + WS_U) + (size_t)MP * DM, DM, rs, 16};
              const bool cf = bid & 1;
              if (cf && li == 0) convert_tasks(reopaque(C), T_WIN + 8320, T_WIN + 16640);
              pg8::gemm_phase(C.lds, g, S, E);
              if (!cf && li == 0) convert_tasks(reopaque(C), T_WIN + 8320, T_WIN + 16640); }
            { pg8::Gemm g{XB16, WIN, DM, DM, 512, 0}; pg8::ListOrder S{256, C.G, bid, 3, 7, 2};
              pg8::EpiPart E{(float*)(ws + WS_BIN), (size_t)MP * 128, 128, 1};
              pg8::gemm_phase(C.lds, g, S, E); }
            if (li == 0) { pg8::Gemm g{(const bf16_t*)(ws + WS_CMPP), (const bf16_t*)(ws + WS_WC1T), 2048, DM, 512, 0}; pg8::ListOrder S{128, C.G, bid, 3, 7, 1};
              pg8::EpiPart E{(float*)(ws + WS_LA), (size_t)4096 * 256, 256, 0};
              pg8::gemm_phase(C.lds, g, S, E); }
            float* us = sm + SM_US; const float* rss = rs + MP;
            skinny_gemm(reopaque(C), XS16, DM, WIN, DM, 8192, DM, 0, [=](int row, int col, float v) { us[row * 8448 + col] = v * rss[row]; });
            skinny_gemm<1>(reopaque(C), XS16, DM, WIN + (size_t)8192 * DM, DM, NIN - 8192, DM, 0, [=](int row, int col, float v) { us[row * 8448 + 8192 + col] = v * rss[row]; });
        } SEAM(pb);
        if (li == 0) { if (IN(18) && EN(11)) { cmp2_phase(reopaque(C)); } SEAM(18); }
        if (IN(p_att) && EN(12)) {
            att::Tensors T; T.UQ = (const bf16_t*)(ws + WS_U); T.SG = (const bf16_t*)(ws + WS_U) + (size_t)MP * DM; T.BGP = (const float*)(ws + WS_BIN); T.rs = rs;
            T.gate_bias = C.in[27] + li * 96; T.qnorm = C.in[28] + li * HD; T.knorm = C.in[20]; T.lutG = sm + SM_LUT;
            T.KCP = (const bf16_t*)(ws + WS_KCP); T.VCP = (const bf16_t*)(ws + WS_VCP); T.SLCK = (const bf16_t*)(ws + WS_SLCK); T.SLCV = (const bf16_t*)(ws + WS_SLCV);
            T.WINK = (const bf16_t*)(ws + WS_WINK); T.WINV = (const bf16_t*)(ws + WS_WINV); T.AO = (bf16_t*)(ws + WS_XC);
            satt::Src S; S.cslc = C.in[3]; S.swin = C.in[4]; S.ptab = (const int*)C.in[7]; S.kvs = sm + SM_KVS; S.kcs = (const bf16_t*)(ws + WS_KCS); S.vcs = (const bf16_t*)(ws + WS_VCS); S.knorm = C.in[20];
            unsigned* qctr = (unsigned*)(ws + WS_CTL) + CW_QUEUE + li * 64;
            if (tid_now(C.lds) == 0) MISC[16] = __hip_atomic_fetch_add(qctr, 1u, __ATOMIC_RELAXED, __HIP_MEMORY_SCOPE_AGENT);
            __syncthreads();
#pragma unroll 1
            for (;;) {
                const int idx = (int)MISC[16];
                if (idx >= 32 + 1024) break;
                if (idx < 32) { satt::unit(reopaque(C), S, idx >> 2, idx & 3, sm + SM_US, C.in[28] + li * HD, C.in[27] + li * 96, sm + SM_LUT, (bf16_t*)(sm + SM_AOS16));
                    if (tid_now(C.lds) == 0) MISC[16] = __hip_atomic_fetch_add(qctr, 1u, __ATOMIC_RELAXED, __HIP_MEMORY_SCOPE_AGENT);
                    __syncthreads(); }
                else { const int i = idx - 32, qt = 63 - (i >> 4), bg = i & 15; att::attn_unit(C.lds, T, bg >> 2, bg & 3, qt, qctr, MISC + 16); }
            }
        } SEAM(p_att);
        if (IN(p_out) && EN(13)) {
            pg8::Gemm g{(const bf16_t*)(ws + WS_XC), (const bf16_t*)(ws + WS_WOUTT) + (size_t)li * DM * DM, DM, DM, DM, 0}; pg8::StaticOrder S; S.init(MP, DM, C.G, bid);
            const bool cf = bid & 1;
            if (cf && li == 0) convert_tasks(reopaque(C), T_WOUT + 4096, T_WOUT + 8192);
            if (li == 0) { pg8::EpiXRes<false> E{XB16, nullptr, (float*)(ws + WS_YB)}; pg8::gemm_phase(C.lds, g, S, E); }
            else { pg8::EpiXRes<true> E{XB16, C.out + O_YP, nullptr}; pg8::gemm_phase(C.lds, g, S, E); }
            if (!cf && li == 0) convert_tasks(reopaque(C), T_WOUT + 4096, T_WOUT + 8192);
            skinny_gemm<1>(reopaque(C), (const bf16_t*)(sm + SM_AOS16), DM, (const bf16_t*)(ws + WS_WOUTT) + (size_t)li * DM * DM, DM, DM, DM, 0, [=](int row, int col, float v) { xsout[row * DM + col] = xsin[row * DM + col] + v; });
        } SEAM(p_out);
        if (li == 0) { if (IN(21) && EN(14)) { rs_phase(reopaque(C), (const float*)(ws + WS_YB), xsout); split_arrive((unsigned*)(ws + WS_CTL) + CW_SPLIT + 2 * 16, MISC + 8); } }
    }
#undef IN
#undef SEAM
#undef XB16
#undef XS16
#undef XA
#undef XBF
#undef XSA
#undef XSB
}

#ifndef N_LAUNCH_MODE
#define N_LAUNCH_MODE 1
#endif
extern "C" void kernel_launch(void* const* d_in, const int* in_sizes, int n_in, void* d_out, int out_size, void* d_ws, size_t ws_size, hipStream_t stream) {
    static int grid = 0;
    if (grid == 0) {
        if (n_in != 30 || (size_t)out_size != O_END || ws_size < WS_END) { fprintf(stderr, "kernel_launch: unexpected shapes (n_in %d, out %d vs %zu, ws %zu vs %zu); nothing launched\n", n_in, out_size, (size_t)O_END, ws_size, (size_t)WS_END); grid = -1; return; }
        int dev = 0, cus = 0;
        if (hipGetDevice(&dev) != hipSuccess || hipDeviceGetAttribute(&cus, hipDeviceAttributeMultiprocessorCount, dev) != hipSuccess || cus <= 0) { fprintf(stderr, "kernel_launch: device query failed\n"); grid = -1; return; }
        if (hipFuncSetAttribute((const void*)fwd, hipFuncAttributeMaxDynamicSharedMemorySize, LDS_BYTES) != hipSuccess) { fprintf(stderr, "kernel_launch: hipFuncSetAttribute failed\n"); grid = -1; return; }
        int per_cu = 0;
        if (hipOccupancyMaxActiveBlocksPerMultiprocessor(&per_cu, (const void*)fwd, 512, LDS_BYTES) != hipSuccess || per_cu < 1) { fprintf(stderr, "kernel_launch: occupancy query says %d blocks per CU\n", per_cu); }
        (void)hipGetLastError();
        grid = cus;
    }
    if (grid < 0) return;
    (void)hipMemsetAsync((char*)d_ws + WS_CTL, 0, CTL_BYTES, stream);
    Args a{};
    for (int i = 0; i < 30; ++i) a.in[i] = (const float*)d_in[i];
    a.out = (float*)d_out; a.ws = (unsigned char*)d_ws;
#if N_LAUNCH_MODE == 1
    a.ph_lo = 0; a.ph_hi = NPHASE;
    hipLaunchKernelGGL(fwd, dim3(grid), dim3(512), LDS_BYTES, stream, a);
#else
#ifndef DUP_MASK
#define DUP_MASK 0u
#endif
    for (int ph = 0; ph < NPHASE; ++ph) { a.ph_lo = ph; a.ph_hi = ph + 1; hipLaunchKernelGGL(fwd, dim3(grid), dim3(512), LDS_BYTES, stream, a);
        if ((DUP_MASK >> ph) & 1u) hipLaunchKernelGGL(fwd, dim3(grid), dim3(512), LDS_BYTES, stream, a); }
#endif
}
```

```cpp
#include <hip/hip_runtime.h>
#include <cstdio>
#include <cstdint>

#define LAS __attribute__((address_space(3)))
#define GAS __attribute__((address_space(1)))
typedef unsigned short bf16_t;
typedef short bf16x8 __attribute__((ext_vector_type(8)));
typedef short s16x4 __attribute__((ext_vector_type(4)));
typedef float f32x4 __attribute__((ext_vector_type(4)));
typedef float f32x2 __attribute__((ext_vector_type(2)));
typedef float f32x16 __attribute__((ext_vector_type(16)));
typedef unsigned u32x4 __attribute__((ext_vector_type(4)));
typedef unsigned u32x2 __attribute__((ext_vector_type(2)));
#define DI __device__ __forceinline__

constexpr int DM = 4096, SEQ = 2048, NBATCH = 4, MP = NBATCH * SEQ  , NSMP = 8, PAST = 8192;
constexpr int NHEAD = 32, HD = 128, NKV = 4, RPG = 8, NIN = 8288  , NINP = 8448;
constexpr float EPS = 1e-6f, LOG2E = 1.4426950408889634f;
constexpr int NPHASE = 25;

constexpr size_t O_YP = 0, O_YS = O_YP + (size_t)MP * DM, O_PCMP = O_YS + (size_t)NSMP * DM, O_PSLC = O_PCMP + (size_t)MP * 1024,
    O_PWIN = O_PSLC + (size_t)MP * 1024, O_PLRU = O_PWIN + (size_t)NBATCH * 512 * 1024, O_PCONV = O_PLRU + 2 * NBATCH * DM,
    O_SCMP = O_PCONV + 2 * NBATCH * 3 * DM, O_SSLC = O_SCMP + NSMP * 1024, O_SWIN = O_SSLC + NSMP * 1024,
    O_SLRU = O_SWIN + (size_t)NSMP * 512 * 1024, O_SCONV = O_SLRU + 2 * NSMP * DM, O_END = O_SCONV + 2 * NSMP * 3 * DM;

constexpr size_t MiB = 1u << 20;
constexpr size_t WS_CTL = 0, CTL_BYTES = 1 * MiB;
constexpr size_t WS_W1T = 1 * MiB;
constexpr size_t WS_WGT = WS_W1T + 2 * 64 * MiB;
constexpr size_t WS_W2T = WS_WGT + 2 * 4 * MiB;
constexpr size_t WS_WKVT = WS_W2T + 2 * 32 * MiB;
constexpr size_t WS_WINT = WS_WKVT + 24 * MiB;
constexpr size_t WS_WOUTT = WS_WINT + 2 * 66 * MiB;
constexpr size_t WS_WC1T = WS_WOUTT + 2 * 32 * MiB;
constexpr size_t WS_WC2T = WS_WC1T + 4 * MiB;
constexpr size_t WS_SMALL = WS_WC2T + 1 * MiB;
constexpr size_t WS_CMPS = WS_SMALL + 2 * MiB;
constexpr size_t WS_XB16 = WS_CMPS + 129 * MiB;
constexpr size_t WS_U = WS_XB16 + 65 * MiB;
constexpr size_t WS_XC = WS_U + 128 * MiB;
constexpr size_t WS_LA = WS_XC + 64 * MiB;
constexpr size_t WS_BIN = WS_LA + 64 * MiB;
constexpr size_t WS_HG = WS_BIN + 64 * MiB;
constexpr size_t WS_XA = WS_HG + 64 * MiB;
constexpr size_t WS_XBF = WS_XA + 128 * MiB;
constexpr size_t WS_WINRAW = WS_XBF + 128 * MiB;
constexpr size_t WS_SLCK = WS_WINRAW + 32 * MiB;
constexpr size_t WS_SLCV = WS_SLCK + 8 * MiB, WS_WINK = WS_SLCV + 8 * MiB, WS_WINV = WS_WINK + 8 * MiB;
constexpr size_t WS_CMPP = WS_WINV + 8 * MiB;
constexpr size_t WS_HIDS = WS_CMPP + 17 * MiB;
constexpr size_t WS_KCS = WS_HIDS + 16 * MiB, WS_VCS = WS_KCS + 4 * MiB;
constexpr size_t WS_KCP = WS_VCS + 4 * MiB, WS_VCP = WS_KCP + 1 * MiB;
constexpr size_t WS_AGG = WS_VCP + 1 * MiB;
constexpr size_t WS_XB16B = WS_AGG + 2 * MiB;
constexpr size_t WS_YB = WS_XB16B + 65 * MiB;
constexpr size_t WS_END = WS_YB + 64 * MiB;
constexpr int SM_RS = 0;
constexpr int SM_SP8 = 8448;
constexpr int SM_POSBP = SM_SP8 + 8192;
constexpr int SM_POSB = SM_POSBP + 8192;
constexpr int SM_LUT = SM_POSB + 512;
constexpr int SM_XS = SM_LUT + 32 * 132;
constexpr int SM_XS16 = SM_XS + 2 * 32768;
constexpr int SM_US = SM_XS16 + 16384;
constexpr int SM_XCS16 = SM_US + 8 * 8448;
constexpr int SM_XCS = SM_XCS16 + 16384;
constexpr int SM_GS = SM_XCS + 32768;
constexpr int SM_HGS16 = SM_GS + 65536;
constexpr int SM_KVS = SM_HGS16 + 16384;
constexpr int SM_AOS16 = SM_KVS + 8 * 3072;
constexpr int SM_XS16B = SM_AOS16 + 16384;
constexpr int SM_ONES = SM_XS16B + 16384;
constexpr int SM_END = SM_ONES + 8192;
static_assert((size_t)SM_END * 4 <= 2 * MiB, "small region");
constexpr int CW_BAR = 4096, CW_QUEUE = 8192;

constexpr int LDS_MAIN = 147712;
constexpr int LDS_MISC = LDS_MAIN;
constexpr int LDS_WTAB = LDS_MAIN + 256;
constexpr int LDS_BYTES = LDS_MAIN + 512;

DI int hw_wave_key() { return (int)__builtin_amdgcn_s_getreg((5 << 11) | 4); }
DI int tid_now(LAS unsigned char* lds) { const int wv = __builtin_amdgcn_readfirstlane(((volatile LAS int*)(lds + LDS_WTAB))[hw_wave_key()]); int l;
    asm volatile("v_mbcnt_lo_u32_b32 %0, -1, 0\n\tv_mbcnt_hi_u32_b32 %0, -1, %0" : "=v"(l)); return wv * 64 + l; }
DI int tid_now_st(volatile LAS unsigned* st) { return tid_now((LAS unsigned char*)(st - 8) - LDS_MISC); }
DI float bf2f(unsigned v) { return __uint_as_float(v << 16); }
DI unsigned cvt_pk_bf16(float lo, float hi) { unsigned r; asm volatile("v_cvt_pk_bf16_f32 %0, %1, %2" : "=v"(r) : "v"(lo), "v"(hi)); return r; }
DI float lo_bf(unsigned w) { return __uint_as_float(w << 16); }
DI float hi_bf(unsigned w) { return __uint_as_float(w & 0xffff0000u); }
DI float frcp(float x) { return __builtin_amdgcn_rcpf(x); }
DI float fsqrt(float x) { return __builtin_amdgcn_sqrtf(x); }
DI float frsq(float x) { return __builtin_amdgcn_rsqf(x); }
DI float fexp(float x) { return __builtin_amdgcn_exp2f(x * 1.4426950408889634f); }
DI float sigmoidf_(float x) { return frcp(1.f + __builtin_amdgcn_exp2f(x * -1.4426950408889634f)); }
DI float siluf_(float x) { return x * sigmoidf_(x); }
template <int O> DI float shx(float v) { static_assert(O >= 1 && O < 32, "ds_swizzle xor mask"); return __int_as_float(__builtin_amdgcn_ds_swizzle(__float_as_int(v), (O << 10) | 0x1f)); }
template <int O> DI unsigned shxu(unsigned v) { return (unsigned)__builtin_amdgcn_ds_swizzle((int)v, (O << 10) | 0x1f); }
DI float half_sum(float v) { auto rr = __builtin_amdgcn_permlane32_swap(__float_as_uint(v), __float_as_uint(v), false, false); return __uint_as_float(rr[0]) + __uint_as_float(rr[1]); }
DI float half_max(float v) { auto rr = __builtin_amdgcn_permlane32_swap(__float_as_uint(v), __float_as_uint(v), false, false); return fmaxf(__uint_as_float(rr[0]), __uint_as_float(rr[1])); }
DI float half_other(float v, int hi) { auto rr = __builtin_amdgcn_permlane32_swap(__float_as_uint(v), __float_as_uint(v), false, false); return __uint_as_float(hi ? rr[0] : rr[1]); }
DI float sum32(float v) { v += shx<1>(v); v += shx<2>(v); v += shx<4>(v); v += shx<8>(v); v += shx<16>(v); return v; }
DI float sum16(float v) { v += shx<1>(v); v += shx<2>(v); v += shx<4>(v); v += shx<8>(v); return v; }
DI float max32(float v) { v = fmaxf(v, shx<1>(v)); v = fmaxf(v, shx<2>(v)); v = fmaxf(v, shx<4>(v)); v = fmaxf(v, shx<8>(v)); v = fmaxf(v, shx<16>(v)); return v; }
DI float wave_sum(float v) { return half_sum(sum32(v)); }
DI float wave_max(float v) { return half_max(max32(v)); }
DI u32x4 pack8f(const float* v) { u32x4 w; w.x = cvt_pk_bf16(v[0], v[1]); w.y = cvt_pk_bf16(v[2], v[3]); w.z = cvt_pk_bf16(v[4], v[5]); w.w = cvt_pk_bf16(v[6], v[7]); return w; }
DI void unpack8(u32x4 w, float* v) { v[0] = lo_bf(w.x); v[1] = hi_bf(w.x); v[2] = lo_bf(w.y); v[3] = hi_bf(w.y); v[4] = lo_bf(w.z); v[5] = hi_bf(w.z); v[6] = lo_bf(w.w); v[7] = hi_bf(w.w); }

#define XB_TMO      128
#define XB_XCNT(j)  (256  + 64 * (j))
#define XB_XSUB(j)  (1280 + 64 * (j))
#define XB_XGEN(j)  (2304 + 64 * (j))
#define XB_TOP      3328
#define XB_TOPGEN   3392
#define XCD_BAR_WORDS 3456
#define XB_SPIN_CAP (1u << 18)
__device__ __forceinline__ unsigned xb_ld(unsigned* p)              { return __hip_atomic_load(p, __ATOMIC_RELAXED, __HIP_MEMORY_SCOPE_AGENT); }
__device__ __forceinline__ unsigned xb_add(unsigned* p, unsigned v) { return __hip_atomic_fetch_add(p, v, __ATOMIC_RELAXED, __HIP_MEMORY_SCOPE_AGENT); }
__device__ __forceinline__ unsigned xb_xcc_id() { return (unsigned)__builtin_amdgcn_s_getreg((3 << 11) | 20) & 0xFu; }
#define XB_SPIN(cond, bar) do { unsigned _sp = 0; while (cond) { __builtin_amdgcn_s_sleep(1); \
    if ((++_sp & 255u) == 0u) { if (xb_ld(&(bar)[XB_TMO])) break; if (_sp > XB_SPIN_CAP) { atomicAdd(&(bar)[XB_TMO], 1u); break; } } } } while (0)
struct XcdBarrier { unsigned* bar; unsigned x; volatile LAS unsigned* st; };
__device__ __forceinline__ XcdBarrier xcd_barrier_post(unsigned* bar, volatile LAS unsigned* st) {
    XcdBarrier b; b.bar = bar; b.x = xb_xcc_id(); b.st = st;
    if (tid_now_st(st) == 0) (void)xb_add(&bar[XB_XCNT(b.x)], 1u);
    return b;
}
__device__ __forceinline__ void xcd_barrier_complete(unsigned* bar, unsigned x, unsigned& nloc, unsigned& nx) {
    const unsigned G = gridDim.x * gridDim.y * gridDim.z;
    unsigned sum, cnt, mine, sp = 0u;
    for (;;) {
        sum = 0u; cnt = 0u; mine = 0u;
#pragma unroll 1
        for (unsigned j = 0; j < 16; ++j) { const unsigned c = xb_ld(&bar[XB_XCNT(j)]); sum += c; cnt += (c > 0u) ? 1u : 0u; mine = (j == x) ? c : mine; }
        if (sum == G) break;
        __builtin_amdgcn_s_sleep(1);
        if ((++sp & 255u) == 0u) { if (xb_ld(&bar[XB_TMO])) break; if (sp > XB_SPIN_CAP) { atomicAdd(&bar[XB_TMO], 1u); break; } }
    }
    nloc = mine > 0u ? mine : 1u; nx = cnt > 0u ? cnt : 1u;
}
__device__ __forceinline__ void xcd_barrier(const XcdBarrier& b) {
    asm volatile("s_waitcnt vmcnt(0)" ::: "memory");
    __syncthreads();
    if (tid_now_st(b.st) == 0) {
        unsigned* bar = b.bar;
        __builtin_amdgcn_s_waitcnt(0);
        unsigned nloc = b.st[0], nx = b.st[1];
        if (nloc == 0u) { xcd_barrier_complete(bar, b.x, nloc, nx); b.st[0] = nloc; b.st[1] = nx; }
        const unsigned old = xb_add(&bar[XB_XSUB(b.x)], 1u);
        const unsigned gen = old / nloc;
        if (old + 1u == (gen + 1u) * nloc) {
            __builtin_amdgcn_fence(__ATOMIC_RELEASE, "agent");
            asm volatile("s_waitcnt vmcnt(0)" ::: "memory");
            const unsigned og = xb_add(&bar[XB_TOP], 1u);
            const unsigned tg = og / nx;
            if (og + 1u == (tg + 1u) * nx) xb_add(&bar[XB_TOPGEN], 1u);
            else XB_SPIN(xb_ld(&bar[XB_TOPGEN]) == tg, bar);
            __builtin_amdgcn_fence(__ATOMIC_ACQUIRE, "agent");
            xb_add(&bar[XB_XGEN(b.x)], 1u);
            asm volatile("s_waitcnt vmcnt(0)" ::: "memory");
        } else {
            XB_SPIN(xb_ld(&bar[XB_XGEN(b.x)]) == gen, bar);
            __builtin_amdgcn_fence(__ATOMIC_ACQUIRE, "agent");
            asm volatile("s_waitcnt vmcnt(0)" ::: "memory");
        }
    }
    __syncthreads();
}

namespace pg8 {
constexpr int BM = 256, BK = 64, HALF = 128, HTB = HALF * BK * 2, STAGE_BYTES = 8 * HTB, NXCD = 8, WGM = 8;
__host__ __device__ __forceinline__ int lds_byte(int r, int c) { const int st = (r >> 4) * 2 + (c >> 5), rr = r & 15, cc = c & 31, ob = rr * 64 + cc * 2; return st * 1024 + (ob ^ (((ob >> 9) & 1) << 5)); }
__host__ __device__ __forceinline__ void stage_rc(int b, int& R, int& C) { const int st = b / 1024, sb = b % 1024, swz = sb ^ (((sb >> 9) & 1) << 5); R = (st >> 1) * 16 + swz / 64; C = (st & 1) * 32 + (swz % 64) / 2; }
__host__ __device__ __forceinline__ int perm32(int rho) { const int n = rho >> 4, i = rho & 15; return 8 * (i >> 2) + 4 * n + (i & 3); }

struct Unit { int pm, pn, ks; };
struct Gemm { const bf16_t* A; const bf16_t* Bt; int lda, ldb, K, ablk;
    DI const char* a_ptr(const Unit& u) const { return (const char*)(A + (size_t)u.pm * BM * lda + (size_t)u.ks * K + (ablk ? (u.pn >> 1) * 256 : 0)); }
    DI const char* b_ptr(const Unit& u) const { return (const char*)(Bt + (size_t)u.pn * BM * ldb + (size_t)u.ks * K); }
};
struct StaticOrder {
    int nM, nN, nwg, G, c;
    DI void init(int M, int N, int G_, int c_) { nM = M / BM; nN = N / BM; nwg = nM * nN; G = G_; c = c_; }
    DI bool next(int i, Unit& u) const {
        const long L = (long)i * G + c; if (L >= nwg) return false;
        int wgid = (int)L; { const int q = nwg / NXCD, r = nwg % NXCD, xcd = wgid % NXCD, off = wgid / NXCD; wgid = (xcd < r ? xcd * (q + 1) : r * (q + 1) + (xcd - r) * q) + off; }
        const int nig = WGM * nN, gid = wgid / nig, fm = gid * WGM, gsz = (nM - fm) < WGM ? (nM - fm) : WGM;
        u.pm = fm + ((wgid % nig) % gsz); u.pn = (wgid % nig) / gsz; u.ks = 0; return true;
    }
};
struct RangeOrder {
    StaticOrder S; int lo, hi;
    DI bool next(int i, Unit& u) const { const int k = lo + i; if (k >= hi) return false; return S.next(k, u); }
};
struct ListOrder {
    int total, G, c, kshift, kmask, mode;
    DI bool next(int i, Unit& u) const {
        const int L = i * G + c; if (c < 0 || L >= total) return false;
        u.pm = L >> kshift; u.ks = L & kmask; u.pn = mode == 0 ? (u.pm >> 6) : mode == 1 ? (u.pm >> 3) : 32; return true;
    }
};

template <class Epi, class Sched>
__device__ __forceinline__ void gemm_phase(LAS unsigned char* lds, const Gemm g, const Sched& S, const Epi& E) {
    int tid = tid_now(lds); asm volatile("" : "+v"(tid));
    const int wid = __builtin_amdgcn_readfirstlane(tid >> 6), lane = tid & 63, wr = wid >> 2, wc = wid & 3, fr = lane & 15, fq = lane >> 4;
    const int K = g.K, nt = K / BK;
    unsigned voffA, voffB;
    { int R, C; stage_rc(tid * 16, R, C); const int Rb = Epi::PERM ? ((R & ~31) + perm32(R & 31)) : R;
      voffA = (unsigned)(R * g.lda + C) * 2u; voffB = (unsigned)(Rb * g.ldb + C) * 2u; }
    const size_t rstep_voffA = (size_t)64 * g.lda * 2, rstep_voffB = (size_t)64 * g.ldb * 2;
    const size_t kstep = (size_t)(BK * 2);
    const size_t hstepA = (size_t)HALF * g.lda * 2, hstepB = (size_t)HALF * g.ldb * 2;
    const unsigned ldsw = (unsigned)wid * 1024u;
    const int aoff = lds_byte(wr * 64 + fr, fq * 8), boff = lds_byte(wc * 32 + fr, fq * 8);
#define PG8_SA(b, h) (((b) * 2 + (h)) * HTB)
#define PG8_SB(b, h) ((4 + (b) * 2 + (h)) * HTB)
#define PG8_STAGE(bufoff, gbase, voff) do { _Pragma("unroll") for (int _i = 0; _i < 2; ++_i) \
        __builtin_amdgcn_global_load_lds((const unsigned*)((const char*)(gbase) + (size_t)_i * rstep_##voff + (voff)), (LAS unsigned*)(lds + (bufoff) + ldsw + _i * 8192), 16, 0, 0); } while (0)
#define PG8_LDA(dst, b, h) do { _Pragma("unroll") for (int m = 0; m < 4; ++m) _Pragma("unroll") for (int k = 0; k < 2; ++k) dst[m][k] = *(const LAS bf16x8*)(lds + PG8_SA(b, h) + aoff + m * 2048 + k * 1024); } while (0)
#define PG8_LDB(dst, b, h) do { _Pragma("unroll") for (int n = 0; n < 2; ++n) _Pragma("unroll") for (int k = 0; k < 2; ++k) dst[n][k] = *(const LAS bf16x8*)(lds + PG8_SB(b, h) + boff + n * 2048 + k * 1024); } while (0)
#define PG8_MMA(ai, bj, At, Bt) do { __builtin_amdgcn_s_setprio(1); _Pragma("unroll") for (int m = 0; m < 4; ++m) _Pragma("unroll") for (int n = 0; n < 2; ++n) _Pragma("unroll") for (int k = 0; k < 2; ++k) \
        acc[ai][bj][m][n] = __builtin_amdgcn_mfma_f32_16x16x32_bf16(Bt[n][k], At[m][k], acc[ai][bj][m][n], 0, 0, 0); __builtin_amdgcn_s_setprio(0); } while (0)
#define PG8_WAIT_V(n) asm volatile("s_waitcnt vmcnt(" #n ")" ::: "memory")
#define PG8_WAIT_L(n) asm volatile("s_waitcnt lgkmcnt(" #n ")" ::: "memory")
#define PG8_BAR __builtin_amdgcn_s_barrier()
#define PG8_SCHED __builtin_amdgcn_sched_barrier(0)
    Unit cur, nxt; int ui = 0;
    if (!S.next(0, cur)) return;
    f32x4 acc[2][2][4][2];
#pragma unroll
    for (int a = 0; a < 2; ++a)
#pragma unroll
        for (int b = 0; b < 2; ++b)
#pragma unroll
            for (int m = 0; m < 4; ++m)
#pragma unroll
                for (int n = 0; n < 2; ++n) acc[a][b][m][n] = (f32x4){0.f, 0.f, 0.f, 0.f};
    bf16x8 At[4][2], B0[2][2], B1[2][2];
    const char* cA = g.a_ptr(cur); const char* cB = g.b_ptr(cur);
    PG8_STAGE(PG8_SB(0, 0), cB, voffB); PG8_STAGE(PG8_SB(0, 1), cB + hstepB, voffB); PG8_STAGE(PG8_SA(0, 0), cA, voffA); PG8_STAGE(PG8_SA(0, 1), cA + hstepA, voffA);
    if (wr == 1) PG8_BAR;
    PG8_WAIT_V(2); PG8_BAR;
    PG8_STAGE(PG8_SB(1, 0), cB + kstep, voffB); PG8_STAGE(PG8_SA(1, 0), cA + kstep, voffA); PG8_STAGE(PG8_SB(1, 1), cB + hstepB + kstep, voffB);
    PG8_WAIT_V(6); PG8_BAR;
    for (;;) {
        const bool has_next = S.next(ui + 1, nxt);
        const char* nA = has_next ? g.a_ptr(nxt) : cA; const char* nB = has_next ? g.b_ptr(nxt) : cB;
        for (int t = 0; t < nt; t += 2) {
            const bool last = (t == nt - 2);
            const char* a1 = cA + (size_t)(t + 1) * kstep;
            const char* a2 = last ? nA : cA + (size_t)(t + 2) * kstep; const char* b2 = last ? nB : cB + (size_t)(t + 2) * kstep;
            const char* a3 = a2 + kstep; const char* b3 = b2 + kstep;
            PG8_LDB(B0, 0, 0); PG8_LDB(B1, 0, 1); PG8_SCHED; PG8_LDA(At, 0, 0); PG8_STAGE(PG8_SA(1, 1), a1 + hstepA, voffA);
            PG8_WAIT_V(8); PG8_WAIT_L(0); PG8_BAR; PG8_MMA(0, 0, At, B0); PG8_MMA(0, 1, At, B1); PG8_BAR; PG8_SCHED;
            PG8_LDA(At, 0, 1); PG8_STAGE(PG8_SB(0, 0), b2, voffB); PG8_STAGE(PG8_SB(0, 1), b2 + hstepB, voffB); PG8_STAGE(PG8_SA(0, 0), a2, voffA);
            PG8_WAIT_V(8); PG8_WAIT_L(0); PG8_BAR; PG8_MMA(1, 0, At, B0); PG8_MMA(1, 1, At, B1); PG8_BAR; PG8_SCHED;
            PG8_LDB(B0, 1, 0); PG8_LDB(B1, 1, 1); PG8_SCHED; PG8_LDA(At, 1, 0); PG8_STAGE(PG8_SA(0, 1), a2 + hstepA, voffA);
            PG8_WAIT_V(8); PG8_WAIT_L(0); PG8_BAR; PG8_MMA(0, 0, At, B0); PG8_MMA(0, 1, At, B1); PG8_BAR; PG8_SCHED;
            PG8_LDA(At, 1, 1); PG8_STAGE(PG8_SB(1, 0), b3, voffB); PG8_STAGE(PG8_SB(1, 1), b3 + hstepB, voffB); PG8_STAGE(PG8_SA(1, 0), a3, voffA);
            PG8_WAIT_V(8); PG8_WAIT_L(0); PG8_BAR; PG8_MMA(1, 0, At, B0); PG8_MMA(1, 1, At, B1); PG8_BAR; PG8_SCHED;
        }
        if (wr == 0) PG8_BAR;
        E(acc, cur, wr, wc, fr, fq);
        if (!has_next) break;
#pragma unroll
        for (int a = 0; a < 2; ++a)
#pragma unroll
            for (int b = 0; b < 2; ++b)
#pragma unroll
                for (int m = 0; m < 4; ++m)
#pragma unroll
                    for (int n = 0; n < 2; ++n) acc[a][b][m][n] = (f32x4){0.f, 0.f, 0.f, 0.f};
        cur = nxt; cA = nA; cB = nB; ++ui;
        if (wr == 1) PG8_BAR;
    }
    PG8_WAIT_V(0);
    PG8_BAR;
#undef PG8_SA
#undef PG8_SB
#undef PG8_STAGE
#undef PG8_LDA
#undef PG8_LDB
#undef PG8_MMA
#undef PG8_WAIT_V
#undef PG8_WAIT_L
#undef PG8_BAR
#undef PG8_SCHED
}

#define EPI_ARGS const f32x4 (&acc)[2][2][4][2], const Unit& u, int wr, int wc, int fr, int fq
struct EpiBf16Rs {
    static constexpr bool PERM = true;
    bf16_t* O; bf16_t* O2; int ldc; const float* rs; int split_pn;
    DI void operator()(EPI_ARGS) const {
        const int row0 = u.pm * BM + wr * 64 + fr; const bool second = u.pn >= split_pn;
        bf16_t* base = second ? O2 : O; const int col0 = (second ? u.pn - split_pn : u.pn) * BM + wc * 32 + 8 * fq;
        float rsv[8];
#pragma unroll
        for (int rg = 0; rg < 8; ++rg) rsv[rg] = rs[row0 + (rg >> 2) * HALF + (rg & 3) * 16];
#pragma unroll
        for (int ai = 0; ai < 2; ++ai)
#pragma unroll
            for (int m = 0; m < 4; ++m) { const int row = row0 + ai * HALF + m * 16; const float s = rsv[ai * 4 + m]; bf16_t* rowp = base + (size_t)row * ldc + col0;
#pragma unroll
                for (int bj = 0; bj < 2; ++bj) { f32x4 v0 = acc[ai][bj][m][0] * s, v1 = acc[ai][bj][m][1] * s;
                    if (second) {
#pragma unroll
                        for (int j = 0; j < 4; ++j) { v0[j] = siluf_(v0[j]); v1[j] = siluf_(v1[j]); } }
                    u32x4 w; w.x = cvt_pk_bf16(v0[0], v0[1]); w.y = cvt_pk_bf16(v0[2], v0[3]); w.z = cvt_pk_bf16(v1[0], v1[1]); w.w = cvt_pk_bf16(v1[2], v1[3]);
                    *(u32x4*)(rowp + bj * HALF) = w; }
                asm volatile("" ::: "memory"); }
    }
};
struct EpiGate {
    static constexpr bool PERM = true;
    const bf16_t* XC; bf16_t* LA; bf16_t* BIN; const float* brg; const float* big; const float* sp8;
    DI void operator()(EPI_ARGS) const {
        const int row0 = u.pm * BM + wr * 64 + fr; const int cb = (u.pn >> 1) * 256 + (u.pn & 1) * 128 + wc * 32 + 8 * fq;
        float sp[8]; unsigned bri[8];
        { const f32x4 a0 = *(const f32x4*)(brg + cb), a1 = *(const f32x4*)(brg + cb + 4), c0 = *(const f32x4*)(big + cb), c1 = *(const f32x4*)(big + cb + 4), s0 = *(const f32x4*)(sp8 + cb), s1 = *(const f32x4*)(sp8 + cb + 4);
#pragma unroll
          for (int j = 0; j < 4; ++j) { bri[j] = cvt_pk_bf16(a0[j], c0[j]); bri[4 + j] = cvt_pk_bf16(a1[j], c1[j]); sp[j] = s0[j]; sp[4 + j] = s1[j]; } }
        u32x4 xq[2];
#pragma unroll
        for (int rg = 0; rg < 2; ++rg) xq[rg] = *(const u32x4*)(XC + (size_t)(row0 + rg * 16) * DM + cb);
#pragma unroll
        for (int rg = 0; rg < 8; ++rg) { const int ai = rg >> 2, m = rg & 3; const int row = row0 + ai * HALF + m * 16; const size_t off = (size_t)row * DM + cb;
            const u32x4 xw = xq[rg & 1];
            if (rg < 6) xq[rg & 1] = *(const u32x4*)(XC + (size_t)(row0 + ((rg + 2) >> 2) * HALF + ((rg + 2) & 3) * 16) * DM + cb);
            float xc[8]; unpack8(xw, xc);
            const bool first = (row & (SEQ - 1)) == 0;
            float la[8], bi[8];
#pragma unroll
            for (int e = 0; e < 8; ++e) { const float ar = acc[ai][0][m][e >> 2][e & 3] + lo_bf(bri[e]), ag = acc[ai][1][m][e >> 2][e & 3] + hi_bf(bri[e]);
                const float r = sigmoidf_(ar), ig = sigmoidf_(ag); const float l = sp[e] * r; la[e] = l;
                const float a2 = fexp(2.f * l); const float mult = first ? 1.f : fsqrt(fmaxf(1.f - a2, 0.f)); bi[e] = mult * ig * xc[e]; }
            *(u32x4*)(LA + off) = pack8f(la); *(u32x4*)(BIN + off) = pack8f(bi);
            asm volatile("" ::: "memory"); }
    }
};
struct EpiRes {
    static constexpr bool PERM = false;
    const float* base; float* out; int ldc;
    DI void operator()(EPI_ARGS) const {
        const int row0 = u.pm * BM + wr * 64 + fr, col0 = u.pn * BM + wc * 32 + 4 * fq;
        f32x4 cur[4];
        { const size_t off = (size_t)row0 * ldc + col0;
#pragma unroll
          for (int q = 0; q < 4; ++q) cur[q] = *(const f32x4*)(base + off + (q >> 1) * HALF + (q & 1) * 16); }
#pragma unroll
        for (int rg = 0; rg < 8; ++rg) { const int ai = rg >> 2, m = rg & 3; const size_t off = (size_t)(row0 + ai * HALF + m * 16) * ldc + col0;
            f32x4 nx[4];
            if (rg < 7) { const size_t offn = (size_t)(row0 + ((rg + 1) >> 2) * HALF + ((rg + 1) & 3) * 16) * ldc + col0;
#pragma unroll
                for (int q = 0; q < 4; ++q) nx[q] = *(const f32x4*)(base + offn + (q >> 1) * HALF + (q & 1) * 16); }
#pragma unroll
            for (int q = 0; q < 4; ++q) *(f32x4*)(out + off + (q >> 1) * HALF + (q & 1) * 16) = cur[q] + acc[ai][q >> 1][m][q & 1];
            if (rg < 7) {
#pragma unroll
                for (int q = 0; q < 4; ++q) cur[q] = nx[q]; }
            asm volatile("" ::: "memory"); }
    }
};
template <bool F32OUT>
struct EpiXRes {
    static constexpr bool PERM = true;
    bf16_t* X; float* OF; float* part; LAS unsigned char* patch = nullptr;
    DI void operator()(EPI_ARGS) const {
        const int row0 = u.pm * BM + wr * 64 + fr, col0 = u.pn * BM + wc * 32 + 8 * fq;
        u32x4 cur[2]; float ssv[8];
        { const size_t off = (size_t)row0 * DM + col0; cur[0] = *(const u32x4*)(X + off); cur[1] = *(const u32x4*)(X + off + HALF); }
#pragma unroll
        for (int rg = 0; rg < 8; ++rg) { const int ai = rg >> 2, m = rg & 3; const size_t off = (size_t)(row0 + ai * HALF + m * 16) * DM + col0;
            u32x4 nx[2];
            if (rg < 7) { const size_t offn = (size_t)(row0 + ((rg + 1) >> 2) * HALF + ((rg + 1) & 3) * 16) * DM + col0;
                nx[0] = *(const u32x4*)(X + offn); nx[1] = *(const u32x4*)(X + offn + HALF); }
            float ss = 0.f;
#pragma unroll
            for (int bj = 0; bj < 2; ++bj) { float v[8]; unpack8(cur[bj], v);
#pragma unroll
                for (int e = 0; e < 8; ++e) v[e] += acc[ai][bj][m][e >> 2][e & 3];
                if (F32OUT) {
                    LAS unsigned char* pt = patch + (wr * 4 + wc) * 2048;
                    *(LAS f32x4*)(pt + fr * 128 + (((fq * 2) ^ (fr & 7)) << 4)) = (f32x4){v[0], v[1], v[2], v[3]};
                    *(LAS f32x4*)(pt + fr * 128 + (((fq * 2 + 1) ^ (fr & 7)) << 4)) = (f32x4){v[4], v[5], v[6], v[7]};
                    const int ln = fq * 16 + fr, c = ln & 7; float* ob = OF + (size_t)(u.pm * BM + wr * 64 + ai * HALF + m * 16) * DM + u.pn * BM + bj * HALF + wc * 32 + c * 4;
#pragma unroll
                    for (int j = 0; j < 2; ++j) { const int row = j * 8 + (ln >> 3); *(f32x4*)(ob + (size_t)row * DM) = *(LAS const f32x4*)(pt + row * 128 + ((c ^ (row & 7)) << 4)); } }
                else {
#pragma unroll
                    for (int e = 0; e < 8; ++e) ss += v[e] * v[e];
                    *(u32x4*)(X + off + bj * HALF) = pack8f(v); } }
            ssv[rg] = ss;
            if (rg < 7) { cur[0] = nx[0]; cur[1] = nx[1]; }
            asm volatile("" ::: "memory"); }
        if (!F32OUT) {
#pragma unroll
            for (int rg = 0; rg < 8; ++rg) { float t = ssv[rg]; t += shx<16>(t); t = half_sum(t); ssv[rg] = t; }
            if (fq == 0) { float* pp = part + (size_t)(u.pn * 4 + wc) * MP + row0;
#pragma unroll
                for (int rg = 0; rg < 8; ++rg) pp[(rg >> 2) * HALF + (rg & 3) * 16] = ssv[rg]; } }
    }
};
struct EpiKV {
    static constexpr bool PERM = false;
    float* o_cmp; float* o_slc; float* o_win; const float* rs;
    DI void operator()(EPI_ARGS) const {
        float* dst = o_cmp + (size_t)(u.pn >> 2) * ((size_t)MP * 1024); if (u.pn >= 8) dst = o_win;
        const int row0 = u.pm * BM + wr * 64 + fr, col0 = (u.pn & 3) * BM + wc * 32 + 4 * fq;
        float rsv[8];
#pragma unroll
        for (int rg = 0; rg < 8; ++rg) rsv[rg] = rs[row0 + (rg >> 2) * HALF + (rg & 3) * 16];
#pragma unroll
        for (int ai = 0; ai < 2; ++ai)
#pragma unroll
            for (int m = 0; m < 4; ++m) { const int row = row0 + ai * HALF + m * 16; const float s = rsv[ai * 4 + m]; float* rowp = dst + (size_t)row * 1024 + col0;
#pragma unroll
                for (int bj = 0; bj < 2; ++bj)
#pragma unroll
                    for (int n = 0; n < 2; ++n) *(f32x4*)(rowp + bj * HALF + n * 16) = acc[ai][bj][m][n] * s;
                asm volatile("" ::: "memory"); }
    }
};
struct EpiPart {
    static constexpr bool PERM = false;
    float* P; size_t ks_stride; int ldc; int half_only;
    DI void operator()(EPI_ARGS) const {
        float* dst = P + (size_t)u.ks * ks_stride; const int row0 = u.pm * BM + wr * 64 + fr, col0 = wc * 32 + 4 * fq;
#pragma unroll
        for (int ai = 0; ai < 2; ++ai)
#pragma unroll
            for (int m = 0; m < 4; ++m) { float* rowp = dst + (size_t)(row0 + ai * HALF + m * 16) * ldc + col0;
#pragma unroll
                for (int bj = 0; bj < 2; ++bj) { if (bj == 1 && half_only) continue;
#pragma unroll
                    for (int n = 0; n < 2; ++n) *(f32x4*)(rowp + bj * HALF + n * 16) = acc[ai][bj][m][n]; } }
    }
};
struct EpiHidS {
    static constexpr bool PERM = true;
    bf16_t* O; const float* posb;
    DI void operator()(EPI_ARGS) const {
        const int row0 = u.pm * BM + wr * 64 + fr, col0 = wc * 32 + 8 * fq; const float* pb = posb + u.pn * 256;
        f32x4 bv[2][2];
#pragma unroll
        for (int bj = 0; bj < 2; ++bj)
#pragma unroll
            for (int n = 0; n < 2; ++n) bv[bj][n] = *(const f32x4*)(pb + col0 + bj * HALF + 4 * n);
#pragma unroll
        for (int ai = 0; ai < 2; ++ai)
#pragma unroll
            for (int m = 0; m < 4; ++m) { bf16_t* rowp = O + (size_t)(row0 + ai * HALF + m * 16) * 256 + col0;
#pragma unroll
                for (int bj = 0; bj < 2; ++bj) { f32x4 v0 = acc[ai][bj][m][0] + bv[bj][0], v1 = acc[ai][bj][m][1] + bv[bj][1];
#pragma unroll
                    for (int j = 0; j < 4; ++j) { v0[j] = siluf_(v0[j]); v1[j] = siluf_(v1[j]); }
                    u32x4 w; w.x = cvt_pk_bf16(v0[0], v0[1]); w.y = cvt_pk_bf16(v0[2], v0[3]); w.z = cvt_pk_bf16(v1[0], v1[1]); w.w = cvt_pk_bf16(v1[2], v1[3]);
                    *(u32x4*)(rowp + bj * HALF) = w; } }
    }
};
}

namespace att {
constexpr int SHM_T = 16384;
constexpr int V_OFF = 0, K_OFF = 2 * SHM_T, WSC_OFF = 4 * SHM_T, LUT_OFF = WSC_OFF + 8 * 64 * 4, REV_OFF = LUT_OFF + 8 * 132 * 4, REV_N = 296, REV_ZERO = 224, IMP_OFF = 81920,
    IMPX_OFF = IMP_OFF + 32768  , OT_OFF = IMP_OFF  , MASK_OFF = IMP_OFF + 65536, ATT_END = MASK_OFF + 128;
static_assert(REV_OFF + 8 * REV_N * 4 <= IMP_OFF && ATT_END <= LDS_MAIN, "attention LDS map");
#define KSWZ(row, colB) ((row) * 256 + ((colB) ^ (((row) & 7) << 4)))
DI int v_rd_base(int lane) { return ((lane & 3) << 3) | (((lane >> 2) & 3) << 6) | (((lane >> 4) & 1) << 5) | (((lane >> 5) & 1) << 8); }
constexpr int v_rd_off(int d0, int ks, int half) { return d0 * 512 + ks * 4096 + half * 2048; }
DI int crow(int r, int hi) { return (r & 3) + 8 * (r >> 2) + 4 * hi; }
DI float swap_max(float v) { return half_max(v); }
DI float swap_add(float v) { return half_sum(v); }

DI void pack_p(const f32x16& p0, const f32x16& p1, bf16x8& pa0, bf16x8& pa1, bf16x8& pa2, bf16x8& pa3) {
#define PK4(P, B_, OUT) do { unsigned a0 = cvt_pk_bf16(P[B_+0], P[B_+1]), a1 = cvt_pk_bf16(P[B_+2], P[B_+3]);                          \
        unsigned b0 = cvt_pk_bf16(P[B_+4], P[B_+5]), b1 = cvt_pk_bf16(P[B_+6], P[B_+7]);                                             \
        auto r0 = __builtin_amdgcn_permlane32_swap(a0, b0, false, false); auto r1 = __builtin_amdgcn_permlane32_swap(a1, b1, false, false); \
        u32x4 w = {r0[0], r1[0], r0[1], r1[1]}; OUT = *reinterpret_cast<bf16x8*>(&w); } while (0)
    PK4(p0, 0, pa0); PK4(p0, 8, pa1); PK4(p1, 0, pa2); PK4(p1, 8, pa3);
#undef PK4
}

struct Branch { const bf16_t* K; const bf16_t* V; unsigned long long tiles; int kshift, koff, dmax; };
struct Pos { int tid, wid, lane, r32, hi; unsigned kso[2], vso[2]; int vb0; };

DI void issue_tile(LAS unsigned char* lds, const Pos& P, const Branch& B, int j, int buf) {
    const char* ks = (const char*)B.K + (size_t)j * SHM_T; const char* vs = (const char*)B.V + (size_t)j * SHM_T;
#pragma unroll
    for (int i = 0; i < 2; ++i)
        __builtin_amdgcn_global_load_lds((const unsigned*)(ks + P.kso[i]), (LAS unsigned*)(lds + K_OFF + buf * SHM_T + (P.wid * 2 + i) * 1024), 16, 0, 0);
#pragma unroll
    for (int i = 0; i < 2; ++i)
        __builtin_amdgcn_global_load_lds((const unsigned*)(vs + P.vso[i]), (LAS unsigned*)(lds + V_OFF + buf * SHM_T + (P.wid * 2 + i) * 1024), 16, 0, 0);
}
DI int first_tile(unsigned long long tiles) { return tiles ? __builtin_ctzll(tiles) : -1; }
DI int next_tile(unsigned long long tiles, int j) { const unsigned long long m = (j >= 63) ? 0ull : (tiles >> (j + 1)); return m ? j + 1 + __builtin_ctzll(m) : -1; }

DI void qkt(f32x16& p0, f32x16& p1, LAS const unsigned char* Kb, int r32, int hi, const bf16x8* qr) {
    LAS const unsigned char* kb[4];
#pragma unroll
    for (int dd = 0; dd < 4; ++dd) kb[dd] = Kb + KSWZ(r32, (dd * 16 + hi * 8) * 2);
    bf16x8 fa[4][2], fb[4][2];
    __builtin_amdgcn_sched_barrier(0);
#pragma unroll
    for (int d0 = 0; d0 < 4; ++d0) { fa[d0][0] = *(LAS const bf16x8*)(kb[d0]); fa[d0][1] = *(LAS const bf16x8*)(kb[d0] + 32 * 256); }
#pragma unroll
    for (int d0 = 0; d0 < 4; ++d0) { fb[d0][0] = *(LAS const bf16x8*)(kb[d0] + 128); fb[d0][1] = *(LAS const bf16x8*)(kb[d0] + 128 + 32 * 256); }
    __builtin_amdgcn_sched_barrier(0);
    asm volatile("s_waitcnt lgkmcnt(8)" ::: "memory");
    __builtin_amdgcn_sched_barrier(0);
#pragma unroll
    for (int d0 = 0; d0 < 4; ++d0) { p0 = __builtin_amdgcn_mfma_f32_32x32x16_bf16(fa[d0][0], qr[d0], p0, 0, 0, 0); p1 = __builtin_amdgcn_mfma_f32_32x32x16_bf16(fa[d0][1], qr[d0], p1, 0, 0, 0); }
    __builtin_amdgcn_sched_barrier(0);
    asm volatile("s_waitcnt lgkmcnt(0)" ::: "memory");
    __builtin_amdgcn_sched_barrier(0);
#pragma unroll
    for (int d0 = 0; d0 < 4; ++d0) { p0 = __builtin_amdgcn_mfma_f32_32x32x16_bf16(fb[d0][0], qr[4 + d0], p0, 0, 0, 0); p1 = __builtin_amdgcn_mfma_f32_32x32x16_bf16(fb[d0][1], qr[4 + d0], p1, 0, 0, 0); }
    __builtin_amdgcn_sched_barrier(0);
}
DI void pv_tile(f32x16* o, int vb, bf16x8 pa0, bf16x8 pa1, bf16x8 pa2, bf16x8 pa3) {
#define TRRD(dst, off) asm volatile("ds_read_b64_tr_b16 %0, %1 offset:%2" : "=&v"(dst) : "v"(vb), "i"(off) : "memory")
#define PV_LD(ks, L, H) do { TRRD(L[0], v_rd_off(0, ks, 0)); TRRD(H[0], v_rd_off(0, ks, 1)); TRRD(L[1], v_rd_off(1, ks, 0)); TRRD(H[1], v_rd_off(1, ks, 1)); \
                             TRRD(L[2], v_rd_off(2, ks, 0)); TRRD(H[2], v_rd_off(2, ks, 1)); TRRD(L[3], v_rd_off(3, ks, 0)); TRRD(H[3], v_rd_off(3, ks, 1)); } while (0)
#define PV_MM(pa, L, H) do { _Pragma("unroll") for (int d0 = 0; d0 < 4; ++d0) \
        o[d0] = __builtin_amdgcn_mfma_f32_32x32x16_bf16(pa, (bf16x8){L[d0][0], L[d0][1], L[d0][2], L[d0][3], H[d0][0], H[d0][1], H[d0][2], H[d0][3]}, o[d0], 0, 0, 0); } while (0)
    s16x4 la[4], ha[4], lb[4], hb[4];
    PV_LD(0, la, ha);
    PV_LD(1, lb, hb);
    asm volatile("s_waitcnt lgkmcnt(8)" ::: "memory"); __builtin_amdgcn_sched_barrier(0);
    PV_MM(pa0, la, ha); __builtin_amdgcn_sched_barrier(0);
    PV_LD(2, la, ha);
    asm volatile("s_waitcnt lgkmcnt(8)" ::: "memory"); __builtin_amdgcn_sched_barrier(0);
    PV_MM(pa1, lb, hb); __builtin_amdgcn_sched_barrier(0);
    PV_LD(3, lb, hb);
    asm volatile("s_waitcnt lgkmcnt(8)" ::: "memory"); __builtin_amdgcn_sched_barrier(0);
    PV_MM(pa2, la, ha); __builtin_amdgcn_sched_barrier(0);
    asm volatile("s_waitcnt lgkmcnt(0)" ::: "memory"); __builtin_amdgcn_sched_barrier(0);
    PV_MM(pa3, lb, hb);
#undef PV_LD
#undef PV_MM
#undef TRRD
}

DI void softmax_pv(f32x16& p0, f32x16& p1, float off, f32x16* o, int vb, float& lsum) {
#define TRRD(dst, o_) asm volatile("ds_read_b64_tr_b16 %0, %1 offset:%2" : "=&v"(dst) : "v"(vb), "i"(o_) : "memory")
#define PV_LD(ks, L, H) do { TRRD(L[0], v_rd_off(0, ks, 0)); TRRD(H[0], v_rd_off(0, ks, 1)); TRRD(L[1], v_rd_off(1, ks, 0)); TRRD(H[1], v_rd_off(1, ks, 1)); \
                             TRRD(L[2], v_rd_off(2, ks, 0)); TRRD(H[2], v_rd_off(2, ks, 1)); TRRD(L[3], v_rd_off(3, ks, 0)); TRRD(H[3], v_rd_off(3, ks, 1)); } while (0)
#define PV_MM(pa, L, H) do { _Pragma("unroll") for (int d0 = 0; d0 < 4; ++d0) \
        o[d0] = __builtin_amdgcn_mfma_f32_32x32x16_bf16(pa, (bf16x8){L[d0][0], L[d0][1], L[d0][2], L[d0][3], H[d0][0], H[d0][1], H[d0][2], H[d0][3]}, o[d0], 0, 0, 0); } while (0)
#define SM_CHUNK(P, B_, OUT) do { _Pragma("unroll") for (int e_ = 0; e_ < 8; ++e_) { P[B_ + e_] = __builtin_amdgcn_exp2f(P[B_ + e_] + off); ps += P[B_ + e_]; } \
        unsigned a0 = cvt_pk_bf16(P[B_+0], P[B_+1]), a1 = cvt_pk_bf16(P[B_+2], P[B_+3]), b0 = cvt_pk_bf16(P[B_+4], P[B_+5]), b1 = cvt_pk_bf16(P[B_+6], P[B_+7]); \
        auto r0 = __builtin_amdgcn_permlane32_swap(a0, b0, false, false); auto r1 = __builtin_amdgcn_permlane32_swap(a1, b1, false, false); \
        u32x4 w_ = {r0[0], r1[0], r0[1], r1[1]}; OUT = *reinterpret_cast<bf16x8*>(&w_); } while (0)
    s16x4 la[4], ha[4], lb[4], hb[4]; float ps = 0.f; bf16x8 pa;
    PV_LD(0, la, ha); PV_LD(1, lb, hb);
    __builtin_amdgcn_sched_barrier(0);
    SM_CHUNK(p0, 0, pa);
    asm volatile("s_waitcnt lgkmcnt(8)" ::: "memory"); __builtin_amdgcn_sched_barrier(0);
    PV_MM(pa, la, ha); __builtin_amdgcn_sched_barrier(0);
    PV_LD(2, la, ha);
    SM_CHUNK(p0, 8, pa);
    asm volatile("s_waitcnt lgkmcnt(8)" ::: "memory"); __builtin_amdgcn_sched_barrier(0);
    PV_MM(pa, lb, hb); __builtin_amdgcn_sched_barrier(0);
    PV_LD(3, lb, hb);
    SM_CHUNK(p1, 0, pa);
    asm volatile("s_waitcnt lgkmcnt(8)" ::: "memory"); __builtin_amdgcn_sched_barrier(0);
    PV_MM(pa, la, ha); __builtin_amdgcn_sched_barrier(0);
    SM_CHUNK(p1, 8, pa);
    asm volatile("s_waitcnt lgkmcnt(0)" ::: "memory"); __builtin_amdgcn_sched_barrier(0);
    PV_MM(pa, lb, hb);
    lsum += swap_add(ps);
#undef SM_CHUNK
#undef PV_MM
#undef PV_LD
#undef TRRD
}

template <bool CMP>
DI void do_tile(LAS unsigned char* lds, const Pos& P, const Branch& B, int j, int buf, int t0, int tq, bool rowok, const bf16x8* qr, f32x16* o, float& lsum, float mub) {
    LAS const float* lutw = (LAS const float*)(lds + LUT_OFF) + P.wid * 132;
    LAS const unsigned char* Kb = (LAS const unsigned char*)(lds + K_OFF + buf * SHM_T);
    const float NEG = -__builtin_inff();
    const int kmin = (j * 64) << B.kshift, kmax = (j * 64 + 63) << B.kshift;
    const int dlo = (t0 - B.koff) - kmax, dhi = (t0 + 31 - B.koff) - kmin;
    f32x16 p0, p1; float off;
    if (dlo >= 128 && dhi <= B.dmax) {
        off = rowok ? lutw[128] - mub : NEG;
#pragma unroll
        for (int r = 0; r < 16; ++r) { p0[r] = 0.f; p1[r] = 0.f; }
        qkt(p0, p1, Kb, P.r32, P.hi, qr);
    } else if (B.kshift == 0 && dhi <= B.dmax) {
        off = rowok ? -mub : NEG;
        LAS const float* rv = (LAS const float*)(lds + REV_OFF) + P.wid * REV_N + (REV_ZERO - (tq - j * 64 - 4 * P.hi));
#pragma unroll
        for (int r = 0; r < 16; ++r) { const int c = (r & 3) + 8 * (r >> 2); p0[r] = rv[c]; p1[r] = rv[c + 32]; }
        qkt(p0, p1, Kb, P.r32, P.hi, qr);
    } else {
        off = rowok ? -mub : NEG;
        const int dq = tq - (((j * 64) + 4 * P.hi) << B.kshift);
#pragma unroll
        for (int r = 0; r < 16; ++r) { const int c = (r & 3) + 8 * (r >> 2);
            const int d0 = dq - (c << B.kshift), d1 = dq - ((c + 32) << B.kshift);
            p0[r] = lutw[min(max(d0, 0), 128)]; p1[r] = lutw[min(max(d1, 0), 128)]; }
        asm volatile("s_waitcnt lgkmcnt(0)" ::: "memory");
#pragma unroll
        for (int r = 0; r < 16; ++r) { const int c = (r & 3) + 8 * (r >> 2);
            const int d0 = dq - (c << B.kshift), d1 = dq - ((c + 32) << B.kshift);
            p0[r] = ((unsigned)d0 <= (unsigned)B.dmax) ? p0[r] : NEG;
            p1[r] = ((unsigned)d1 <= (unsigned)B.dmax) ? p1[r] : NEG; }
        qkt(p0, p1, Kb, P.r32, P.hi, qr);
    }
    if (!CMP) { softmax_pv(p0, p1, off, o, P.vb0 + buf * SHM_T, lsum); return; }
#pragma unroll
    for (int r = 0; r < 16; ++r) { p0[r] = __builtin_amdgcn_exp2f(p0[r] + off); p1[r] = __builtin_amdgcn_exp2f(p1[r] + off); }
    float ps = 0.f;
#pragma unroll
    for (int r = 0; r < 16; ++r) ps += p0[r] + p1[r];
    lsum += swap_add(ps);
    if (CMP) {
        LAS float* impw = (LAS float*)(lds + IMP_OFF) + (P.wid * 32 + P.r32) * 32 + j * 16 + P.hi;
        float prev = 0.f;
#pragma unroll
        for (int x = 0; x < 8; ++x) { const int gq = x & 3; const f32x16& pp = x < 4 ? p0 : p1;
            const float ownv = pp[4 * gq] + pp[4 * gq + 1] + pp[4 * gq + 2] + 0.5f * pp[4 * gq + 3], nx = 0.5f * pp[4 * gq + 3];
            const float recv = half_other(nx, P.hi);
            impw[2 * x] = ownv + (P.hi ? recv : prev); prev = recv;
            if (x == 7 && P.hi && j == 0) ((LAS float*)(lds + IMPX_OFF))[P.wid * 32 + P.r32] = nx; }
    }
    bf16x8 pa0, pa1, pa2, pa3;
    pack_p(p0, p1, pa0, pa1, pa2, pa3);
    pv_tile(o, P.vb0 + buf * SHM_T, pa0, pa1, pa2, pa3);
}
template <bool CMP>
DI void run_branch(LAS unsigned char* lds, const Pos& P, const Branch& B, int& buf, const Branch& NB, int nj, int t0, unsigned rowmask, const bf16x8* qr, f32x16* o, float& lsum, float mub) {
    int j = first_tile(B.tiles);
    const int tq = t0 + P.r32 - B.koff;
    while (j >= 0) {
        asm volatile("s_waitcnt vmcnt(0)" ::: "memory"); __builtin_amdgcn_s_barrier();
        const int jn = next_tile(B.tiles, j);
        if (jn >= 0) issue_tile(lds, P, B, jn, buf ^ 1); else if (nj >= 0) issue_tile(lds, P, NB, nj, buf ^ 1);
        do_tile<CMP>(lds, P, B, j, buf, t0, tq, (rowmask >> (j & 31)) & 1u, qr, o, lsum, mub);
        asm volatile("s_waitcnt lgkmcnt(0)" ::: "memory");
        buf ^= 1; j = jn;
    }
}
template <int STAGE>
DI void fold_branch(LAS unsigned char* lds, const Pos& P, f32x16* o, float fac) {
    LAS float* wsc = (LAS float*)(lds + WSC_OFF) + P.wid * 64; LAS unsigned* otl = (LAS unsigned*)(lds + OT_OFF + P.wid * 8192) + P.lane;
    if (P.hi == 0) wsc[P.r32] = fac;
    asm volatile("s_waitcnt lgkmcnt(0)" ::: "memory");
    float fv[16];
#pragma unroll
    for (int r = 0; r < 16; ++r) fv[r] = wsc[crow(r, P.hi)];
#pragma unroll
    for (int dh = 0; dh < 4; dh += 2) { unsigned wv[16];
        if (STAGE > 0) {
#pragma unroll
            for (int q = 0; q < 16; ++q) wv[q] = otl[(dh * 8 + q) * 64]; }
        __builtin_amdgcn_sched_barrier(0);
#pragma unroll
        for (int r = 0; r < 16; r += 2) { const float f0 = fv[r], f1 = fv[r + 1];
#pragma unroll
            for (int d_ = dh; d_ < dh + 2; ++d_) { float a = o[d_][r] * f0, b = o[d_][r + 1] * f1; LAS unsigned* wp = otl + (d_ * 8 + (r >> 1)) * 64;
                if (STAGE > 0) { const unsigned w = wv[(d_ - dh) * 8 + (r >> 1)]; a += lo_bf(w); b += hi_bf(w); }
                if (STAGE < 2) { *wp = cvt_pk_bf16(a, b); o[d_][r] = 0.f; o[d_][r + 1] = 0.f; } else { o[d_][r] = a; o[d_][r + 1] = b; } } }
        __builtin_amdgcn_sched_barrier(0); }
}

struct Tensors {
    const bf16_t* UQ; const bf16_t* SG; const float* BGP; const float* rs; const float* gate_bias; const float* qnorm; const float* knorm; const float* lutG;
    const bf16_t *KCP, *VCP, *SLCK, *SLCV, *WINK, *WINV; bf16_t* AO;
};
DI void attn_unit(LAS unsigned char* lds, const Tensors& T, int b, int g, int qt, unsigned* qctr, volatile LAS unsigned* qslot) {
    Pos P; P.tid = tid_now(lds); asm volatile("" : "+v"(P.tid)); P.wid = __builtin_amdgcn_readfirstlane(P.tid >> 6); P.lane = P.tid & 63; P.r32 = P.lane & 31; P.hi = P.lane >> 5;
#pragma unroll
    for (int i = 0; i < 2; ++i) { const int pc = P.wid * 2 + i;
        { const int row = pc * 4 + (P.lane >> 4), cpos = P.lane & 15; P.kso[i] = (unsigned)(row * 256 + ((cpos ^ (row & 7)) << 4)); }
        { const int q = pc * 64 + P.lane, sub = q >> 5, kk = (sub >> 2) * 8 + ((q >> 2) & 7), c = (sub & 3) * 32 + (q & 3) * 8;
          const int k = (kk & ~0xC) | ((kk & 4) << 1) | ((kk & 8) >> 1); P.vso[i] = (unsigned)(k * 256 + c * 2); } }
    P.vb0 = (int)(unsigned)(uintptr_t)(lds + V_OFF) + v_rd_base(P.lane);
    const int t0 = qt * 32, rowg0 = b * SEQ + t0, head = g * RPG + P.wid, slab = b * NKV + g;
    { Branch B0_; B0_.K = T.KCP + (size_t)slab * 128 * HD; B0_.V = T.VCP + (size_t)slab * 128 * HD; issue_tile(lds, P, B0_, 0, 0); }
    float lutv[3], revv[5]; int revd[5];
#pragma unroll
    for (int j = 0; j < 3; ++j) { const int i = P.tid + j * 512; lutv[j] = i < 8 * 132 ? T.lutG[g * 8 * 132 + i] : 0.f; }
#pragma unroll
    for (int j = 0; j < 5; ++j) { const int i = P.tid + j * 512; const int ii = i < 8 * REV_N ? i : 0; const int w = ii / REV_N, d = REV_ZERO - (ii - w * REV_N); revd[j] = d;
        revv[j] = T.lutG[(g * 8 + w) * 132 + (d < 0 ? 0 : (d < 128 ? d : 128))]; }
    const float* lgp = T.lutG + (g * 8 + P.wid) * 132;
    const float qn_a = T.qnorm[P.lane], qn_b = T.qnorm[64 + P.lane], lg_a = lgp[P.lane], lg_b = lgp[64 + P.lane], lg_c = lgp[128];
    float kn_a[3], kn_b[3];
#pragma unroll
    for (int k = 0; k < 3; ++k) { kn_a[k] = T.knorm[k * HD + P.lane]; kn_b[k] = T.knorm[k * HD + 64 + P.lane]; }
    u32x4 qw[8]; f32x4 qn0[8], qn1[8];
    { const bf16_t* qp = T.UQ + (size_t)(rowg0 + P.r32) * DM + head * HD + P.hi * 8;
#pragma unroll
      for (int d0 = 0; d0 < 8; ++d0) { qw[d0] = *(const u32x4*)(qp + d0 * 16); qn0[d0] = *(const f32x4*)(T.qnorm + d0 * 16 + P.hi * 8); qn1[d0] = *(const f32x4*)(T.qnorm + d0 * 16 + P.hi * 8 + 4); } }
    float bgp[3][8], gbias[3];
    const size_t rowg = (size_t)(rowg0 + P.r32); const float rsv = T.rs[rowg];
#pragma unroll
    for (int k = 0; k < 3; ++k) { gbias[k] = T.gate_bias[head * 3 + k];
#pragma unroll
        for (int ks = 0; ks < 8; ++ks) bgp[k][ks] = T.BGP[((size_t)ks * MP + rowg) * 128 + head * 3 + k]; }
    __builtin_amdgcn_sched_barrier(0);
#pragma unroll
    for (int j = 0; j < 3; ++j) { const int i = P.tid + j * 512; if (i < 8 * 132) ((LAS float*)(lds + LUT_OFF))[i] = lutv[j]; }
#pragma unroll
    for (int j = 0; j < 5; ++j) { const int i = P.tid + j * 512; if (i < 8 * REV_N) ((LAS float*)(lds + REV_OFF))[i] = revd[j] < 0 ? -__builtin_inff() : revv[j]; }
    float mub[3];
    { const float gq = wave_max(fmaxf(fabsf(qn_a), fabsf(qn_b)));
      const float lm = wave_max(fmaxf(fmaxf(lg_a, lg_b), lg_c));
#pragma unroll
      for (int k = 0; k < 3; ++k) { const float gk = wave_max(fmaxf(fabsf(kn_a[k]), fabsf(kn_b[k])));
          mub[k] = 11.3137085f * LOG2E * 1.001f * gq * gk + lm + 0.05f; } }
    bf16x8 qr[8];
    { float qv[8][8]; float ss = 0.f;
#pragma unroll
      for (int d0 = 0; d0 < 8; ++d0) { unpack8(qw[d0], qv[d0]);
#pragma unroll
          for (int e = 0; e < 8; ++e) ss += qv[d0][e] * qv[d0][e]; }
      ss = swap_add(ss);
      const float sc = frsq(ss * (1.f / HD) + EPS) * 0.08838834764831845f * LOG2E;
#pragma unroll
      for (int d0 = 0; d0 < 8; ++d0) { const f32x4 n0 = qn0[d0], n1 = qn1[d0];
          float v[8];
#pragma unroll
          for (int e = 0; e < 4; ++e) { v[e] = qv[d0][e] * sc * n0[e]; v[4 + e] = qv[d0][4 + e] * sc * n1[e]; }
          const u32x4 w = pack8f(v); qr[d0] = *reinterpret_cast<const bf16x8*>(&w); } }
    float bgv[3];
#pragma unroll
    for (int k = 0; k < 3; ++k) { float s_ = 0.f;
#pragma unroll
        for (int ks = 0; ks < 8; ++ks) s_ += bgp[k][ks];
        bgv[k] = sigmoidf_(s_ * rsv + gbias[k]); }
    asm volatile("" : "+v"(bgv[0]), "+v"(bgv[1]), "+v"(bgv[2]));
    f32x16 o[4];
#pragma unroll
    for (int d_ = 0; d_ < 4; ++d_)
#pragma unroll
        for (int r = 0; r < 16; ++r) o[d_][r] = 0.f;
    const int cur = t0 >> 6;
    const bool need_sel = t0 >= 1024;
    Branch BC, BS, BW;
    BC.K = T.KCP + (size_t)slab * 128 * HD; BC.V = T.VCP + (size_t)slab * 128 * HD; BC.kshift = 4; BC.koff = 31; BC.dmax = 0x3fffffff; BC.tiles = ((t0 >> 4) + 1) > 64 ? 3ull : 1ull;
    BS.K = T.SLCK + (size_t)slab * SEQ * HD; BS.V = T.SLCV + (size_t)slab * SEQ * HD; BS.kshift = 0; BS.koff = 0; BS.dmax = 0x3fffffff; BS.tiles = 1ull;
    BW.K = T.WINK + (size_t)slab * SEQ * HD; BW.V = T.WINV + (size_t)slab * SEQ * HD; BW.kshift = 0; BW.koff = 0; BW.dmax = 512;
    { const int jlo = t0 > 512 ? (t0 - 512) >> 6 : 0; BW.tiles = ((2ull << cur) - 1ull) & ~((1ull << jlo) - 1ull); }
    asm volatile("s_waitcnt vmcnt(0) lgkmcnt(0)" ::: "memory"); __builtin_amdgcn_s_barrier();
    int buf = 0;
    float fac_c;
    {
        float lsum = 0.f;
        run_branch<true>(lds, P, BC, buf, BS, 0, t0, 0xffffffffu, qr, o, lsum, mub[0]);
        const float inv = lsum > 0.f ? frcp(lsum) : 0.f;
        fac_c = bgv[0] * inv;
        if (P.hi == 0) ((LAS float*)(lds + IMPX_OFF))[256 + P.wid * 32 + P.r32] = inv;
    }
    asm volatile("s_waitcnt lgkmcnt(0)" ::: "memory"); __builtin_amdgcn_s_barrier();
    {
        LAS unsigned* selm = (LAS unsigned*)(lds + MASK_OFF);
        if (need_sel) {
#pragma unroll
            for (int pass = 0; pass < 2; ++pass) { const int q = P.wid * 4 + pass * 2 + P.hi, jb = P.r32; float v = 0.f;
                float raw_[8], car_[8], inv_[8];
#pragma unroll
                for (int w = 0; w < 8; ++w) { LAS const float* xs_ = (LAS const float*)(lds + IMPX_OFF); raw_[w] = ((LAS const float*)(lds + IMP_OFF))[(w * 32 + q) * 32 + jb]; car_[w] = xs_[w * 32 + q]; inv_[w] = xs_[256 + w * 32 + q]; }
                __builtin_amdgcn_sched_barrier(0);
#pragma unroll
                for (int w = 0; w < 8; ++w) v += (raw_[w] + (jb == 16 ? car_[w] : 0.f)) * inv_[w];
                const int cq = (t0 + q) >> 6; const bool forced = (jb == 0) || (jb == cq) || (jb == cq - 1), allowed = jb <= cq;
                const float score = forced ? 1e30f : (allowed ? v : -1e30f);
                int rank = 0;
#pragma unroll
                for (int k0 = 0; k0 < 32; k0 += 16) { float sk[16];
#pragma unroll
                    for (int u = 0; u < 16; ++u) sk[u] = __int_as_float(__builtin_amdgcn_ds_bpermute(((P.lane & 32) + k0 + u) << 2, __float_as_int(score)));
                    __builtin_amdgcn_sched_barrier(0);
#pragma unroll
                    for (int u = 0; u < 16; ++u) rank += (sk[u] > score || (sk[u] == score && k0 + u < jb)) ? 1 : 0;
                    __builtin_amdgcn_sched_barrier(0); }
                const unsigned long long bal = __ballot(rank < 16 && allowed);
                if (P.r32 == 0) selm[q] = P.hi ? (unsigned)(bal >> 32) : (unsigned)bal; }
        } else if (P.tid < 32) { const int cq = (t0 + P.tid) >> 6; selm[P.tid] = (2u << cq) - 1u; }
    }
    asm volatile("s_waitcnt lgkmcnt(0)" ::: "memory"); __builtin_amdgcn_s_barrier();
    fold_branch<0>(lds, P, o, fac_c);
    {
        const unsigned mymask = ((LAS const unsigned*)(lds + MASK_OFF))[P.r32];
        unsigned un = mymask;
        un |= shxu<1>(un); un |= shxu<2>(un); un |= shxu<4>(un); un |= shxu<8>(un); un |= shxu<16>(un);
        BS.tiles = (unsigned long long)(un & ((2u << cur) - 1u)) | 1ull;
        float lsum = 0.f;
        run_branch<false>(lds, P, BS, buf, BW, first_tile(BW.tiles), t0, mymask, qr, o, lsum, mub[1]);
        fold_branch<1>(lds, P, o, lsum > 0.f ? bgv[1] * frcp(lsum) : 0.f);
    }
    {
        float lsum = 0.f;
        run_branch<false>(lds, P, BW, buf, BW, -1, t0, 0xffffffffu, qr, o, lsum, mub[2]);
        fold_branch<2>(lds, P, o, lsum > 0.f ? bgv[2] * frcp(lsum) : 0.f);
    }
    asm volatile("s_waitcnt lgkmcnt(0)" ::: "memory"); __builtin_amdgcn_s_barrier();
    unsigned nxt_unit = 0;
    if (P.tid == 0) nxt_unit = __hip_atomic_fetch_add(qctr, 1u, __ATOMIC_RELAXED, __HIP_MEMORY_SCOPE_AGENT);
    {
        LAS float* stg = (LAS float*)(lds + P.wid * 16384);
        u32x4 gwv[8];
#pragma unroll
        for (int it = 0; it < 8; ++it) { const int gid = it * 64 + P.lane, row = gid >> 4, c8 = gid & 15; gwv[it] = *(const u32x4*)(T.SG + (size_t)(rowg0 + row) * DM + head * HD + c8 * 8); }
        __builtin_amdgcn_sched_barrier(0);
#pragma unroll
        for (int d_ = 0; d_ < 4; ++d_)
#pragma unroll
            for (int r = 0; r < 16; ++r) stg[crow(r, P.hi) * 128 + d_ * 32 + P.r32] = o[d_][r];
        asm volatile("s_waitcnt lgkmcnt(0)" ::: "memory");
#pragma unroll
        for (int it = 0; it < 8; ++it) { const int gid = it * 64 + P.lane, row = gid >> 4, c8 = gid & 15;
            const f32x4 a = *(LAS const f32x4*)(stg + row * 128 + c8 * 8), c = *(LAS const f32x4*)(stg + row * 128 + c8 * 8 + 4);
            const size_t off = (size_t)(rowg0 + row) * DM + head * HD + c8 * 8;
            const u32x4 gw = gwv[it]; float gv[8]; unpack8(gw, gv);
            float v[8];
#pragma unroll
            for (int e = 0; e < 4; ++e) { v[e] = a[e] * gv[e]; v[4 + e] = c[e] * gv[4 + e]; }
            *(u32x4*)(T.AO + off) = pack8f(v); }
    }
    if (P.tid == 0) *qslot = nxt_unit;
    asm volatile("s_waitcnt lgkmcnt(0)" ::: "memory"); __builtin_amdgcn_s_barrier();
}
}

struct Args { const float* in[30]; float* out; unsigned char* ws; int ph_lo, ph_hi; };
struct Ctx {
    LAS unsigned char* lds; const float* const* in; float* out; unsigned char* ws; float* sm;
    int tid, lane, wave, vcu, G;
};
DI Ctx reopaque(Ctx C) { C.tid = tid_now(C.lds); asm volatile("" : "+v"(C.tid)); C.lane = C.tid & 63; C.wave = __builtin_amdgcn_readfirstlane(C.tid >> 6); asm volatile("" : "+s"(C.vcu), "+s"(C.G)); { size_t z_ = 0; asm volatile("" : "+s"(z_)); C.ws += z_; C.sm = (float*)((unsigned char*)C.sm + z_); C.out = (float*)((unsigned char*)C.out + z_); } return C; }
DI int rel_bucket_dev(int d) { if (d < 16) return d; const int v = 16 + (int)(__logf((float)d * (1.f / 16.f)) / __logf(8.f) * 16.f); return v < 31 ? v : 31; }

template <int NSUB = 2, class F>
DI void skinny_gemm(const Ctx& C, const bf16_t* A, int lda, const bf16_t* Bt, int ldb, int N, int K, int ablk, F&& outf) {
    constexpr int KS = 8 / NSUB;
    const int ngroups = N / 16, npairs = (ngroups + NSUB - 1) / NSUB, sub = C.wave / KS, kq4 = C.wave % KS, i = C.lane & 15, kq = C.lane >> 4;
    const int kw = K / KS, steps = kw / 32;
    LAS float* red = (LAS float*)C.lds;
    for (int gp = C.vcu; gp < npairs; gp += C.G) {
        const int grp = gp * NSUB + sub; const bool valid = grp < ngroups; const int col0 = grp * 16;
        f32x4 acc = {0.f, 0.f, 0.f, 0.f};
        if (valid) {
            const bf16_t* ap = A + (size_t)(i & 7) * lda + (ablk ? (col0 >> 9) * 256 : 0) + kq4 * kw + kq * 8;
            const bf16_t* bp = Bt + (size_t)(col0 + i) * ldb + kq4 * kw + kq * 8;
            bf16x8 a0[8], b0[8], a1[8], b1[8];
#define SK_LD(A_, B_, g_) do { _Pragma("unroll") for (int u = 0; u < 8; ++u) if ((g_) * 8 + u < steps) { A_[u] = *(const bf16x8*)(ap + ((g_) * 8 + u) * 32); B_[u] = *(const bf16x8*)(bp + ((g_) * 8 + u) * 32); } } while (0)
#define SK_MM(A_, B_, g_) do { _Pragma("unroll") for (int u = 0; u < 8; ++u) if ((g_) * 8 + u < steps) acc = __builtin_amdgcn_mfma_f32_16x16x32_bf16(A_[u], B_[u], acc, 0, 0, 0); } while (0)
            const int ng = (steps + 7) >> 3;
            SK_LD(a0, b0, 0);
#pragma unroll 1
            for (int g = 0; g < ng; g += 2) {
                if (g + 1 < ng) SK_LD(a1, b1, g + 1);
                __builtin_amdgcn_sched_barrier(0);
                SK_MM(a0, b0, g);
                __builtin_amdgcn_sched_barrier(0);
                if (g + 2 < ng) SK_LD(a0, b0, g + 2);
                __builtin_amdgcn_sched_barrier(0);
                if (g + 1 < ng) SK_MM(a1, b1, g + 1);
                __builtin_amdgcn_sched_barrier(0);
            }
#undef SK_LD
#undef SK_MM
            asm volatile("s_nop 7\n\ts_nop 7" ::: "memory");
        }
        *(LAS f32x4*)(red + C.wave * 256 + C.lane * 4) = acc;
        __syncthreads();
        if (C.tid < 128 * NSUB) { const int sb = C.tid >> 7, idx = C.tid & 127, row = idx >> 4, col = idx & 15, g2 = gp * NSUB + sb;
            if (g2 < ngroups) { const int l2 = (row >> 2) * 16 + col, v = row & 3; float s = 0.f;
#pragma unroll
                for (int q = 0; q < KS; ++q) s += red[(sb * KS + q) * 256 + l2 * 4 + v];
                outf(row, g2 * 16 + col, s); } }
        __syncthreads();
    }
}

struct TrDesc { const float* W; const float* gain; bf16_t* dst; int ldw, k0, n0, nvalid, ldk, drow0; };
DI void tr_load(const TrDesc& d, int lane, float (&v)[64]) {
    if (lane < d.nvalid) { const float* wp = d.W + (size_t)d.k0 * d.ldw + d.n0 + lane;
#pragma unroll
        for (int i = 0; i < 64; ++i) v[i] = __builtin_nontemporal_load(wp + (size_t)i * d.ldw); }
}
DI void tr_store(const TrDesc& d, int lane, float (&v)[64], LAS unsigned char* patch) {
    if (lane < d.nvalid) {
        if (d.gain) {
#pragma unroll
            for (int i = 0; i < 64; ++i) v[i] *= d.gain[d.k0 + i]; }
#pragma unroll
        for (int i = 0; i < 8; ++i) *(LAS u32x4*)(patch + lane * 128 + ((i ^ (lane & 7)) << 4)) = pack8f(v + i * 8); }
    const int rr = lane >> 3, c = lane & 7;
#pragma unroll
    for (int j = 0; j < 8; ++j) { const int row = j * 8 + rr;
        if (row < d.nvalid) { const u32x4 w = *(LAS const u32x4*)(patch + row * 128 + ((c ^ (row & 7)) << 4));
            *(u32x4*)(d.dst + (size_t)(d.drow0 + row) * d.ldk + d.k0 + c * 8) = w; } }
}
DI void norm_row(const float* x, bf16_t* xb, float* rs, int lane, const bf16_t* y = nullptr, float* xnew = nullptr) {
    f32x4 v[16]; float ss = 0.f;
#pragma unroll
    for (int j = 0; j < 16; ++j) v[j] = *(const f32x4*)(x + j * 256 + lane * 4);
    if (y) {
        u32x2 yw[16];
#pragma unroll
        for (int j = 0; j < 16; ++j) yw[j] = *(const u32x2*)(y + j * 256 + lane * 4);
#pragma unroll
        for (int j = 0; j < 16; ++j) { v[j][0] += lo_bf(yw[j].x); v[j][1] += hi_bf(yw[j].x); v[j][2] += lo_bf(yw[j].y); v[j][3] += hi_bf(yw[j].y); *(f32x4*)(xnew + j * 256 + lane * 4) = v[j]; } }
#pragma unroll
    for (int j = 0; j < 16; ++j) ss += v[j][0] * v[j][0] + v[j][1] * v[j][1] + v[j][2] * v[j][2] + v[j][3] * v[j][3];
    ss = wave_sum(ss);
    if (lane == 0) *rs = frsq(ss * (1.f / DM) + EPS);
#pragma unroll
    for (int j = 0; j < 16; ++j) { u32x2 w; w.x = cvt_pk_bf16(v[j][0], v[j][1]); w.y = cvt_pk_bf16(v[j][2], v[j][3]); *(u32x2*)(xb + j * 256 + lane * 4) = w; }
}
constexpr int C1 = 2 * 8192, C2 = 1024, C3 = 2 * 4096, C4 = 3072, C5 = 2 * 8320, C6 = 2 * 4096, C7 = 2 * 256, C8 = 16, C9 = 32768, C10 = MP + NSMP, C11 = 128, C12 = 128, C13 = 66, C14 = 320;
constexpr int T_W1T = 0, T_WGT = T_W1T + C1, T_W2T = T_WGT + C2, T_WKV = T_W2T + C3, T_WIN = T_WKV + C4, T_WOUT = T_WIN + C5, T_WC1 = T_WOUT + C6, T_WC2 = T_WC1 + C7, T_CACHE = T_WC2 + C8,
    T_NORM = T_CACHE + C9, T_SP8 = T_NORM + C10, T_POSB = T_SP8 + C11, T_LUT = T_POSB + C12, T_PAD = T_LUT + C13, T_END = T_PAD + C14;
DI void tr_decode(const Ctx& C, int r, TrDesc& d) {
    unsigned char* ws = C.ws; int kt, nt; d.nvalid = 64; d.ldk = DM; d.gain = nullptr;
    if (r < T_WGT) { const int L = r >> 13, q = r & 8191; kt = q >> 7; nt = q & 127; d.W = C.in[9] + (size_t)L * DM * 8192; d.ldw = 8192; d.gain = C.in[8] + L * DM; d.dst = (bf16_t*)(ws + WS_W1T) + (size_t)L * 8192 * DM; d.drow0 = nt * 64; }
    else if (r < T_W2T) { r -= T_WGT; const int L = r >> 9, q = r & 511, blk = q >> 5, gi = (q >> 4) & 1; kt = (q >> 2) & 3; nt = q & 3; d.W = C.in[gi ? 14 : 12] + (size_t)(L * 16 + blk) * 65536; d.ldw = 256; d.ldk = 256;
        d.dst = (bf16_t*)(ws + WS_WGT) + (size_t)L * 8192 * 256; d.drow0 = (blk * 2 + ((nt * 64) >> 7)) * 256 + gi * 128 + ((nt * 64) & 127); }
    else if (r < T_WKV) { r -= T_W2T; const int L = r >> 12, q = r & 4095; kt = q >> 6; nt = q & 63; d.W = C.in[17] + (size_t)L * DM * DM; d.ldw = DM; d.dst = (bf16_t*)(ws + WS_W2T) + (size_t)L * DM * DM; d.drow0 = nt * 64; }
    else if (r < T_WIN) { r -= T_WKV; kt = r / 48; nt = r % 48; d.W = C.in[19]; d.ldw = 3072; d.gain = C.in[18]; d.dst = (bf16_t*)(ws + WS_WKVT); d.drow0 = nt * 64; }
    else if (r < T_WOUT) { r -= T_WIN; const int L = r / 8320, q = r % 8320; kt = q / 130; nt = q % 130; d.W = C.in[26] + (size_t)L * DM * NIN; d.ldw = NIN; d.nvalid = nt == 129 ? 32 : 64; d.gain = C.in[25] + L * DM; d.dst = (bf16_t*)(ws + WS_WINT) + (size_t)L * NINP * DM; d.drow0 = nt * 64; }
    else if (r < T_WC1) { r -= T_WOUT; const int L = r >> 12, q = r & 4095; kt = q >> 6; nt = q & 63; d.W = C.in[29] + (size_t)L * DM * DM; d.ldw = DM; d.dst = (bf16_t*)(ws + WS_WOUTT) + (size_t)L * DM * DM; d.drow0 = nt * 64; }
    else if (r < T_WC2) { r -= T_WC1; const int s = r >> 8, q = r & 255; kt = q >> 2; nt = q & 3; d.W = C.in[22] + (size_t)s * DM * 256; d.ldw = 256; d.dst = (bf16_t*)(ws + WS_WC1T) + (size_t)s * 256 * DM; d.drow0 = nt * 64; }
    else { r -= T_WC2; const int s = r >> 3, q = r & 7; kt = q >> 1; nt = q & 1; d.W = C.in[23] + (size_t)s * 256 * 128; d.ldw = 128; d.ldk = 256; d.dst = (bf16_t*)(ws + WS_WC2T) + (size_t)s * 128 * 256; d.drow0 = nt * 64; }
    d.k0 = kt * 64; d.n0 = nt * 64;
}
DI void convert_tasks(const Ctx& C, int lo0, int hi0, int lo1 = 0, int hi1 = 0, int lo2 = 0, int hi2 = 0, int lo3 = 0, int hi3 = 0) {
    const int gw = C.vcu * 8 + C.wave, NGW = C.G * 8, lane = C.lane; unsigned char* ws = C.ws;
#pragma unroll 1
    for (int k = 0; k < 4; ++k) { const int lo = k == 0 ? lo0 : k == 1 ? lo1 : k == 2 ? lo2 : lo3, hi = k == 0 ? hi0 : k == 1 ? hi1 : k == 2 ? hi2 : hi3;
    if (lo < T_CACHE) {
#pragma unroll 1
        for (int it = lo + gw; it < hi; it += NGW) { float va[64]; TrDesc da; tr_decode(C, it, da); tr_load(da, lane, va); tr_store(da, lane, va, C.lds + C.wave * 8192); }
        continue; }
#pragma unroll 1
    for (int it = lo + gw; it < hi; it += NGW) {
        int r = it;
        if (r < T_NORM) {
            r -= T_CACHE; const int* ptab = (const int*)C.in[7]; bf16_t* dst = (bf16_t*)(ws + WS_CMPS);
            f32x4 v[2][4]; int bb[2], pp[2];
#pragma unroll
            for (int rr = 0; rr < 2; ++rr) { const int row = r * 2 + rr, b = row >> 13, pos = row & 8191; bb[rr] = b; pp[rr] = pos;
                const float* src = C.in[2] + ((size_t)ptab[b * 64 + (pos >> 7)] * 128 + (pos & 127)) * 1024;
#pragma unroll
                for (int j = 0; j < 4; ++j) v[rr][j] = __builtin_nontemporal_load((const f32x4*)(src + j * 256 + lane * 4)); }
#pragma unroll
            for (int rr = 0; rr < 2; ++rr)
#pragma unroll
                for (int j = 0; j < 4; ++j) { const int pg = 2 * j + (lane >> 5), s = pg >> 2, g = pg & 3; u32x2 w; w.x = cvt_pk_bf16(v[rr][j][0], v[rr][j][1]); w.y = cvt_pk_bf16(v[rr][j][2], v[rr][j][3]);
                    *(u32x2*)(dst + (((size_t)(s * 32 + bb[rr] * 4 + g) * 8192 + pp[rr]) * 128) + (lane & 31) * 4) = w; }
            continue; }
        if (r < T_SP8) { r -= T_NORM; if (r < MP) norm_row(C.in[0] + (size_t)r * DM, (bf16_t*)(ws + WS_XB16) + (size_t)r * DM, C.sm + SM_RS + r, lane);
            else { const int b = r - MP; norm_row(C.in[1] + (size_t)b * DM, (bf16_t*)(C.sm + SM_XS16) + (size_t)b * DM, C.sm + SM_RS + MP + b, lane); } continue; }
        if (r < T_POSB) { r -= T_SP8; const int idx = r * 64 + lane; const float lam = C.in[16][idx]; const float sp = lam > 15.f ? __expf(-lam) : (lam < -15.f ? -lam : log1pf(__expf(-lam))); C.sm[SM_SP8 + idx] = -8.f * sp; C.sm[SM_ONES + idx] = 1.f; continue; }
        if (r < T_LUT) { r -= T_POSB; const int kc = r >> 3, s = (r >> 2) & 1, hq = r & 3, h = hq * 64 + lane; float acc = 0.f; const float* pos = C.in[21] + (size_t)s * DM; const float* w1 = C.in[22] + (size_t)s * DM * 256;
#pragma unroll 1
            for (int k = kc * 256; k < kc * 256 + 256; k += 16) { const float* wp = w1 + (size_t)k * 256 + h; float wv[16];
#pragma unroll
                for (int u = 0; u < 16; ++u) wv[u] = wp[u * 256];
                __builtin_amdgcn_sched_barrier(0);
#pragma unroll
                for (int u = 0; u < 16; ++u) acc += pos[k + u] * wv[u];
                __builtin_amdgcn_sched_barrier(0); }
            C.sm[SM_POSBP + (kc * 2 + s) * 256 + h] = acc; continue; }
        if (r < T_PAD) { r -= T_LUT; const int idx = r * 64 + lane; const int head = idx / 132, i = idx % 132; C.sm[SM_LUT + idx] = C.in[24][rel_bucket_dev(i < 128 ? i : 128) * 32 + head] * LOG2E; continue; }
        { r -= T_PAD; const int L = r / 160, row = NIN + r % 160; bf16_t* dp = (bf16_t*)(ws + WS_WINT) + ((size_t)L * NINP + row) * DM + lane * 64; const u32x4 z = {0u, 0u, 0u, 0u};
#pragma unroll
          for (int i = 0; i < 8; ++i) *(u32x4*)(dp + i * 8) = z; }
    } }
    __syncthreads();
}
DI void conv_phase(const Ctx& C, int L) {
    const bf16_t* U = (const bf16_t*)(C.ws + WS_U); bf16_t* XC = (bf16_t*)(C.ws + WS_XC);
    const float* cw = C.in[10] + (size_t)L * 4 * DM; const float* cb = C.in[11] + (size_t)L * DM;
    const int c0 = C.tid * 8;
    float w[4][8], bia[8];
#pragma unroll
    for (int k = 0; k < 4; ++k) { const f32x4 a = *(const f32x4*)(cw + k * DM + c0), b = *(const f32x4*)(cw + k * DM + c0 + 4);
#pragma unroll
        for (int e = 0; e < 4; ++e) { w[k][e] = a[e]; w[k][4 + e] = b[e]; } }
    { const f32x4 a = *(const f32x4*)(cb + c0), b = *(const f32x4*)(cb + c0 + 4);
#pragma unroll
      for (int e = 0; e < 4; ++e) { bia[e] = a[e]; bia[4 + e] = b[e]; } }
    for (int u = C.vcu; u < 256; u += C.G) {
        const int b = u >> 6, t0 = (u & 63) * 32; const size_t r0 = (size_t)b * SEQ + t0;
        float x0[8], x1[8], x2[8];
        if (t0 == 0) {
#pragma unroll
            for (int e = 0; e < 8; ++e) { x0[e] = 0.f; x1[e] = 0.f; x2[e] = 0.f; } }
        else { unpack8(*(const u32x4*)(U + (r0 - 3) * 8192 + c0), x0); unpack8(*(const u32x4*)(U + (r0 - 2) * 8192 + c0), x1); unpack8(*(const u32x4*)(U + (r0 - 1) * 8192 + c0), x2); }
#pragma unroll 1
        for (int tb = 0; tb < 32; tb += 8) {
            u32x4 xw[8];
#pragma unroll
            for (int i = 0; i < 8; ++i) xw[i] = *(const u32x4*)(U + (r0 + tb + i) * 8192 + c0);
#pragma unroll
            for (int i = 0; i < 8; ++i) { float x3[8], o[8]; unpack8(xw[i], x3);
#pragma unroll
                for (int e = 0; e < 8; ++e) { o[e] = bia[e] + w[0][e] * x0[e] + w[1][e] * x1[e] + w[2][e] * x2[e] + w[3][e] * x3[e]; x0[e] = x1[e]; x1[e] = x2[e]; x2[e] = x3[e]; }
                *(u32x4*)(XC + (r0 + tb + i) * DM + c0) = pack8f(o); }
        }
        if (t0 == SEQ - 32) { float* pc = C.out + O_PCONV + ((size_t)(L * NBATCH + b) * 3) * DM + c0;
#pragma unroll
            for (int e = 0; e < 8; ++e) { pc[e] = x0[e]; pc[DM + e] = x1[e]; pc[2 * DM + e] = x2[e]; } }
    }
}
template <int PASS>
DI void scan_phase(const Ctx& C, int L) {
    const bf16_t* LA = (const bf16_t*)(C.ws + WS_LA); const bf16_t* BIN = (const bf16_t*)(C.ws + WS_BIN); const bf16_t* U = (const bf16_t*)(C.ws + WS_U);
    bf16_t* HG = (bf16_t*)(C.ws + WS_HG); float* AGA = (float*)(C.ws + WS_AGG); float* AGH = AGA + 4 * 16 * DM;
    for (int u = C.vcu; u < 256; u += C.G) {
        const int b = u >> 6, ch = (u >> 2) & 15, slab = u & 3, c0 = slab * 1024 + C.tid * 2; const size_t r0 = (size_t)b * SEQ + ch * 128;
        float h0 = 0.f, h1 = 0.f, s0 = 0.f, s1 = 0.f;
        if (PASS == 3) { for (int j = 0; j < ch; ++j) { const f32x2 a = *(const f32x2*)(AGA + (size_t)(b * 16 + j) * DM + c0), hh = *(const f32x2*)(AGH + (size_t)(b * 16 + j) * DM + c0); h0 = a[0] * h0 + hh[0]; h1 = a[1] * h1 + hh[1]; } }
#pragma unroll 1
        for (int tb = 0; tb < 128; tb += 16) {
            unsigned lw[16], bw[16], gw[16];
#pragma unroll
            for (int i = 0; i < 16; ++i) {
                if (PASS == 3) { lw[i] = __builtin_nontemporal_load((const unsigned*)(LA + (r0 + tb + i) * DM + c0)); bw[i] = __builtin_nontemporal_load((const unsigned*)(BIN + (r0 + tb + i) * DM + c0));
                    gw[i] = __builtin_nontemporal_load((const unsigned*)(U + (r0 + tb + i) * 8192 + DM + c0)); }
                else { lw[i] = *(const unsigned*)(LA + (r0 + tb + i) * DM + c0); bw[i] = *(const unsigned*)(BIN + (r0 + tb + i) * DM + c0); } }
#pragma unroll
            for (int i = 0; i < 16; ++i) { const float l0 = lo_bf(lw[i]), l1 = hi_bf(lw[i]);
                h0 = __builtin_amdgcn_exp2f(l0 * LOG2E) * h0 + lo_bf(bw[i]); h1 = __builtin_amdgcn_exp2f(l1 * LOG2E) * h1 + hi_bf(bw[i]);
                if (PASS == 1) { s0 += l0; s1 += l1; }
                else { *(unsigned*)(HG + (r0 + tb + i) * DM + c0) = cvt_pk_bf16(h0 * siluf_(lo_bf(gw[i])), h1 * siluf_(hi_bf(gw[i]))); } }
        }
        if (PASS == 1) { *(f32x2*)(AGA + (size_t)(b * 16 + ch) * DM + c0) = (f32x2){__expf(s0), __expf(s1)}; *(f32x2*)(AGH + (size_t)(b * 16 + ch) * DM + c0) = (f32x2){h0, h1}; }
        else if (ch == 15) { *(f32x2*)(C.out + O_PLRU + (size_t)(L * NBATCH + b) * DM + c0) = (f32x2){h0, h1}; }
    }
}
DI void rs_phase(const Ctx& C, const float* part, const float* xs) {
    LAS float* red = (LAS float*)C.lds;
    const int rl = C.tid & 31, q = C.tid >> 5;
    for (int r0 = C.vcu * 32; r0 < MP; r0 += C.G * 32) {
        const float* pp = part + (size_t)(q * 4) * MP + r0 + rl;
        const float a0 = pp[0], a1 = pp[MP], a2 = pp[2 * MP], a3 = pp[3 * MP];
        red[q * 32 + rl] = (a0 + a1) + (a2 + a3);
        __syncthreads();
        if (C.tid < 32) { float t = 0.f;
#pragma unroll
            for (int k = 0; k < 16; ++k) t += red[k * 32 + C.tid];
            C.sm[SM_RS + r0 + C.tid] = frsq(t * (1.f / DM) + EPS); }
        __syncthreads();
    }
    const int gw = C.vcu * 8 + C.wave, NGW = C.G * 8;
    for (int b = gw; b < NSMP; b += NGW) norm_row(xs + (size_t)b * DM, (bf16_t*)(C.sm + SM_XS16) + (size_t)b * DM, C.sm + SM_RS + MP + b, C.lane);
}
DI void kvpost_phase(const Ctx& C) {
    const int gw = C.vcu * 8 + C.wave, NGW = C.G * 8, lane = C.lane; const float* knorm = C.in[20];
    const int pgl = lane >> 5, d0 = (lane & 31) * 4;
    for (int r = gw; r < MP; r += NGW) {
        const int b = r >> 11, t = r & 2047;
#pragma unroll
        for (int part = 0; part < 3; ++part) {
            const float* src = part == 0 ? C.out + O_PCMP + (size_t)r * 1024 : (part == 1 ? C.out + O_PSLC + (size_t)r * 1024 : (const float*)(C.ws + WS_WINRAW) + (size_t)r * 1024);
            f32x4 v[4];
#pragma unroll
            for (int j = 0; j < 4; ++j) v[j] = *(const f32x4*)(src + j * 256 + lane * 4);
            if (part == 2 && t >= SEQ - 512) { float* pw = C.out + O_PWIN + ((size_t)b * 512 + (t - (SEQ - 512))) * 1024;
#pragma unroll
                for (int j = 0; j < 4; ++j) *(f32x4*)(pw + j * 256 + lane * 4) = v[j]; }
#pragma unroll
            for (int j = 0; j < 4; ++j) { const int pg = 2 * j + pgl, s = pg >> 2, g = pg & 3; f32x4 x = v[j];
                if (part > 0 && s == 0) { float ss = x[0] * x[0] + x[1] * x[1] + x[2] * x[2] + x[3] * x[3];
                    ss = sum32(ss);
                    const float sc = frsq(ss * (1.f / HD) + EPS); const f32x4 kn = *(const f32x4*)(knorm + part * HD + d0); x = x * sc * kn; }
                u32x2 w; w.x = cvt_pk_bf16(x[0], x[1]); w.y = cvt_pk_bf16(x[2], x[3]);
                bf16_t* dst;
                if (part == 0) dst = (bf16_t*)(C.ws + WS_CMPP) + ((size_t)(s * 16 + b * 4 + g) * SEQ + t) * HD + d0;
                else dst = (bf16_t*)(C.ws + (part == 1 ? (s ? WS_SLCV : WS_SLCK) : (s ? WS_WINV : WS_WINK))) + ((size_t)(b * 4 + g) * SEQ + t) * HD + d0;
                *(u32x2*)dst = w; }
        }
    }
    const float* kvs = C.sm + SM_KVS;
    for (int i = C.vcu * 512 + C.tid; i < NSMP * 2048; i += C.G * 512) { const int b = i >> 11, c = i & 2047; C.out[(c < 1024 ? O_SCMP : O_SSLC - 1024) + (size_t)b * 1024 + c] = kvs[b * 3072 + c]; }
    for (size_t i = (size_t)C.vcu * 512 + C.tid; i < (size_t)NSMP * 512 * 256; i += (size_t)C.G * 512) {
        const int b = (int)(i >> 17), rem = (int)(i & 131071), row = rem >> 8, c4 = rem & 255;
        const f32x4 v = row < 511 ? *(const f32x4*)(C.in[4] + ((size_t)b * 512 + row + 1) * 1024 + c4 * 4) : *(const f32x4*)(kvs + b * 3072 + 2048 + c4 * 4);
        *(f32x4*)(C.out + O_SWIN + ((size_t)b * 512 + row) * 1024 + c4 * 4) = v; }
}
DI void cmp2_phase(const Ctx& C) {
    const int gw = C.vcu * 8 + C.wave, NGW = C.G * 8, lane = C.lane, i = lane & 15, kq = lane >> 4;
    const bf16_t* W2 = (const bf16_t*)(C.ws + WS_WC2T); const bf16_t* HS = (const bf16_t*)(C.ws + WS_HIDS); const float* HP = (const float*)(C.ws + WS_LA);
    const float* posb = C.sm + SM_POSB; const float* kn0 = C.in[20];
    constexpr int NT_S = 32768 / 16, NT_P = 4096 / 16;
    LAS bf16_t* hidt = (LAS bf16_t*)C.lds;
    const int n_s = (NT_S - gw + NGW - 1) / NGW, n_pw = (NT_P - C.vcu + C.G - 1) / C.G, n_p = C.wave == 0 ? n_pw : 0;
    for (int it = 0; it < n_pw + n_s; ++it) {
        const bool prm = it < n_pw; const int m0 = (prm ? C.vcu + it * C.G : gw + (it - n_pw) * NGW) * 16;
        const int s = prm ? (m0 >> 11) : (m0 >> 14);
        if (prm) { const int row = C.tid >> 5, c8 = (C.tid & 31) * 8; f32x4 s0 = *(const f32x4*)(posb + s * 256 + c8), s1 = *(const f32x4*)(posb + s * 256 + c8 + 4);
            f32x4 pv0[8], pv1[8];
#pragma unroll
            for (int ks = 0; ks < 8; ++ks) { const float* p = HP + ((size_t)ks * 4096 + m0 + row) * 256 + c8; pv0[ks] = *(const f32x4*)p; pv1[ks] = *(const f32x4*)(p + 4); }
            __builtin_amdgcn_sched_barrier(0);
#pragma unroll
            for (int ks = 0; ks < 8; ++ks) { s0 += pv0[ks]; s1 += pv1[ks]; }
            float v[8];
#pragma unroll
            for (int e = 0; e < 4; ++e) { v[e] = siluf_(s0[e]); v[4 + e] = siluf_(s1[e]); }
            __syncthreads();
            *(LAS u32x4*)(hidt + row * 256 + c8) = pack8f(v);
            __syncthreads();
            if (C.wave != 0) continue; }
        bf16x8 a[8];
        if (!prm) {
#pragma unroll
            for (int st = 0; st < 8; ++st) a[st] = *(const bf16x8*)(HS + (size_t)(m0 + i) * 256 + st * 32 + kq * 8); }
        else {
#pragma unroll
            for (int st = 0; st < 8; ++st) a[st] = *(LAS const bf16x8*)(hidt + i * 256 + st * 32 + kq * 8); }
        f32x4 acc[8];
        bf16x8 bq[2][8];
#pragma unroll
        for (int st = 0; st < 8; ++st) bq[0][st] = *(const bf16x8*)(W2 + ((size_t)s * 128 + i) * 256 + st * 32 + kq * 8);
#pragma unroll
        for (int nt = 0; nt < 8; ++nt) { acc[nt] = (f32x4){0.f, 0.f, 0.f, 0.f};
            if (nt < 7) {
#pragma unroll
                for (int st = 0; st < 8; ++st) bq[(nt + 1) & 1][st] = *(const bf16x8*)(W2 + ((size_t)s * 128 + (nt + 1) * 16 + i) * 256 + st * 32 + kq * 8); }
            __builtin_amdgcn_sched_barrier(0);
#pragma unroll
            for (int st = 0; st < 8; ++st) acc[nt] = __builtin_amdgcn_mfma_f32_16x16x32_bf16(a[st], bq[nt & 1][st], acc[nt], 0, 0, 0);
            __builtin_amdgcn_sched_barrier(0); }
        float sc[4] = {1.f, 1.f, 1.f, 1.f};
        if (s == 0) {
#pragma unroll
            for (int v = 0; v < 4; ++v) { float ss = 0.f;
#pragma unroll
                for (int nt = 0; nt < 8; ++nt) ss += acc[nt][v] * acc[nt][v];
                ss = sum16(ss);
                sc[v] = frsq(ss * (1.f / HD) + EPS); } }
        bf16_t* dstv[4]; bool okv[4];
#pragma unroll
        for (int v = 0; v < 4; ++v) { const int m = m0 + kq * 4 + v; int slab, n;
            if (!prm) { slab = (m >> 9) & 31; n = m & 511; okv[v] = n < 511; dstv[v] = (bf16_t*)(C.ws + (s ? WS_VCS : WS_KCS)) + ((size_t)slab * 512 + n) * HD; }
            else { slab = (m >> 7) & 15; n = m & 127; okv[v] = n < 127; dstv[v] = (bf16_t*)(C.ws + (s ? WS_VCP : WS_KCP)) + ((size_t)slab * 128 + n) * HD; } }
#pragma unroll
        for (int nt = 0; nt < 8; ++nt) { const int col = nt * 16 + i; const float kn = s == 0 ? kn0[col] : 1.f;
#pragma unroll
            for (int v = 0; v < 4; ++v) { float x = acc[nt][v] * sc[v] * kn; if (!okv[v]) x = 0.f;
                dstv[v][col] = (bf16_t)(cvt_pk_bf16(x, 0.f) & 0xffffu); } }
    }
}
DI void sample_conv(const Ctx& C, int L) {
    const float* cw = C.in[10] + (size_t)L * 4 * DM; const float* cb = C.in[11] + (size_t)L * DM; const float* st = C.in[6] + (size_t)L * NSMP * 3 * DM; const float* us = C.sm + SM_US;
    for (int idx = C.vcu * 512 + C.tid; idx < NSMP * DM; idx += C.G * 512) { const int b = idx >> 12, c = idx & 4095;
        const float s0 = st[(size_t)(b * 3 + 0) * DM + c], s1 = st[(size_t)(b * 3 + 1) * DM + c], s2 = st[(size_t)(b * 3 + 2) * DM + c], xb = us[b * 8448 + c];
        const float xc = cb[c] + cw[c] * s0 + cw[DM + c] * s1 + cw[2 * DM + c] * s2 + cw[3 * DM + c] * xb;
        C.sm[SM_XCS + idx] = xc; ((bf16_t*)(C.sm + SM_XCS16))[idx] = (bf16_t)(cvt_pk_bf16(xc, 0.f) & 0xffffu);
        float* sc = C.out + O_SCONV + ((size_t)(L * NSMP + b) * 3) * DM + c; sc[0] = s1; sc[DM] = s2; sc[2 * DM] = xb; }
}
DI void sample_scan(const Ctx& C, int L) {
    const float* gs = C.sm + SM_GS; const float* us = C.sm + SM_US; const float* brg = C.in[13] + (size_t)L * DM; const float* big = C.in[15] + (size_t)L * DM; const float* sp8 = C.sm + SM_SP8 + L * DM;
    const float* h0p = C.in[5] + (size_t)L * NSMP * DM;
    for (int idx = C.vcu * 512 + C.tid; idx < NSMP * DM; idx += C.G * 512) { const int b = idx >> 12, c = idx & 4095;
        const int colr = ((c >> 8) * 2 + ((c >> 7) & 1)) * 256 + (c & 127);
        const float r = sigmoidf_(gs[b * 8192 + colr] + brg[c]), ig = sigmoidf_(gs[b * 8192 + colr + 128] + big[c]);
        const float la = sp8[c] * r, a = fexp(la), mult = fsqrt(fmaxf(1.f - fexp(2.f * la), 0.f));
        const float h = a * h0p[idx] + mult * ig * C.sm[SM_XCS + idx];
        C.out[O_SLRU + (size_t)L * NSMP * DM + idx] = h;
        ((bf16_t*)(C.sm + SM_HGS16))[idx] = (bf16_t)(cvt_pk_bf16(h * siluf_(us[b * 8448 + DM + c]), 0.f) & 0xffffu); }
}

namespace satt {
constexpr int QS_OFF = 0, LG_OFF = 4096, LG_STRIDE = 1088, KT_OFF = LG_OFF + 8 * LG_STRIDE * 4, VT_OFF = KT_OFF + 64 * 132 * 4, IMP_OFF = VT_OFF + 64 * 128 * 4, LIST_OFF = IMP_OFF + 132 * 4, SEL_OFF = LIST_OFF + 64, S_END = SEL_OFF + 132 * 4;
static_assert(S_END <= LDS_MAIN, "sample attention LDS");
struct Src { const float* cslc; const float* swin; const int* ptab; const float* kvs; const bf16_t* kcs; const bf16_t* vcs; const float* knorm; };
DI void stage_load(const Ctx& C, const Src& S, int kind, int tile, bool is_v, int b, int g, f32x4 (&v)[4]) {
    LAS const int* list = (LAS const int*)(C.lds + LIST_OFF);
    const int sv = is_v ? 1 : 0, slab = b * 4 + g;
#pragma unroll
    for (int i = 0; i < 4; ++i) { const int idx = C.tid + 512 * i, key = idx >> 5, c4 = idx & 31, slot = tile * 64 + key; v[i] = (f32x4){0.f, 0.f, 0.f, 0.f};
        if (kind == 0) { if (slot < 511) { const u32x2 w = *(const u32x2*)((is_v ? S.vcs : S.kcs) + ((size_t)slab * 512 + slot) * HD + c4 * 4); v[i] = (f32x4){lo_bf(w.x), hi_bf(w.x), lo_bf(w.y), hi_bf(w.y)}; } }
        else { const float* p = nullptr;
            if (kind == 1) { const int kpos = list[slot >> 6] * 64 + (slot & 63);
                if (kpos == PAST) p = S.kvs + b * 3072 + 1024 + sv * 512 + g * HD; else if (kpos < PAST) p = S.cslc + (((size_t)S.ptab[b * 64 + (kpos >> 7)] * 128 + (kpos & 127)) * 2 + sv) * 512 + g * HD; }
            else { if (slot < 512) p = S.swin + (((size_t)b * 512 + slot) * 2 + sv) * 512 + g * HD; else if (slot == 512) p = S.kvs + b * 3072 + 2048 + sv * 512 + g * HD; }
            if (p) v[i] = *(const f32x4*)(p + c4 * 4); } }
}
DI void stage_store(const Ctx& C, const Src& S, int kind, bool is_v, f32x4 (&v)[4]) {
    LAS float* Kt = (LAS float*)(C.lds + KT_OFF); LAS float* Vt = (LAS float*)(C.lds + VT_OFF);
#pragma unroll
    for (int i = 0; i < 4; ++i) { const int idx = C.tid + 512 * i, key = idx >> 5, c4 = idx & 31; f32x4 x = v[i];
        if (kind != 0 && !is_v) { float ss = x[0] * x[0] + x[1] * x[1] + x[2] * x[2] + x[3] * x[3];
            ss = sum32(ss);
            const float sc = frsq(ss * (1.f / HD) + EPS); const f32x4 kn = *(const f32x4*)(S.knorm + kind * HD + c4 * 4); x = x * sc * kn; }
        if (is_v) *(LAS f32x4*)(Vt + key * 128 + c4 * 4) = x; else *(LAS f32x4*)(Kt + key * 132 + c4 * 4) = x; }
}
DI bool slot_info(const Ctx& C, int kind, int slot, int& d) {
    LAS const int* list = (LAS const int*)(C.lds + LIST_OFF);
    if (kind == 0) { d = PAST - (16 * slot + 31); return slot < 511; }
    if (kind == 1) { const int kpos = list[slot >> 6] * 64 + (slot & 63); d = PAST - kpos; return kpos <= PAST; }
    d = 512 - slot; return slot <= 512;
}
DI void logits_softmax(const Ctx& C, const Src& S, int kind, int ntiles, int b, int g, const float* lutG) {
    LAS float* lg = (LAS float*)(C.lds + LG_OFF) + C.wave * LG_STRIDE; LAS const float* qs = (LAS const float*)(C.lds + QS_OFF) + C.wave * 128; LAS const float* Kt = (LAS const float*)(C.lds + KT_OFF);
    const float* lut = lutG + (g * 8 + C.wave) * 132;
    f32x4 sa_[4], sb_[4]; stage_load(C, S, kind, 0, false, b, g, sa_); if (ntiles > 1) stage_load(C, S, kind, 1, false, b, g, sb_);
#define SATT_LOGIT_STEP(T_, CUR, NXT) do { \
        stage_store(C, S, kind, false, CUR); \
        __syncthreads(); \
        if ((T_) + 2 < ntiles) stage_load(C, S, kind, (T_) + 2, false, b, g, CUR); \
        float dot = 0.f; \
        _Pragma("unroll 8") for (int d4 = 0; d4 < 32; ++d4) { const f32x4 kv = *(LAS const f32x4*)(Kt + C.lane * 132 + d4 * 4), qv = *(LAS const f32x4*)(qs + d4 * 4); dot += kv[0] * qv[0] + kv[1] * qv[1] + kv[2] * qv[2] + kv[3] * qv[3]; } \
        int d; const bool ok = slot_info(C, kind, (T_) * 64 + C.lane, d); \
        lg[(T_) * 64 + C.lane] = ok ? dot + lut[d < 128 ? (d > 0 ? d : 0) : 128] * 0.6931471805599453f : -__builtin_inff(); \
        __syncthreads(); } while (0)
    for (int t = 0; t < ntiles; t += 2) { SATT_LOGIT_STEP(t, sa_, sb_); if (t + 1 < ntiles) SATT_LOGIT_STEP(t + 1, sb_, sa_); }
#undef SATT_LOGIT_STEP
    float m = -1e30f;
    for (int t = 0; t < ntiles; ++t) m = fmaxf(m, lg[t * 64 + C.lane]);
    m = wave_max(m);
    float s = 0.f;
    for (int t = 0; t < ntiles; ++t) { const float e = __expf(lg[t * 64 + C.lane] - m); lg[t * 64 + C.lane] = e; s += e; }
    s = wave_sum(s); const float inv = s > 0.f ? frcp(s) : 0.f;
    for (int t = 0; t < ntiles; ++t) lg[t * 64 + C.lane] *= inv;
    __syncthreads();
}
DI void pv(const Ctx& C, const Src& S, int kind, int ntiles, int b, int g, float w, float& o0, float& o1) {
    LAS const float* lg = (LAS const float*)(C.lds + LG_OFF) + C.wave * LG_STRIDE; LAS const float* Vt = (LAS const float*)(C.lds + VT_OFF);
    float a0 = 0.f, a1 = 0.f;
    f32x4 sa_[4], sb_[4]; stage_load(C, S, kind, 0, true, b, g, sa_); if (ntiles > 1) stage_load(C, S, kind, 1, true, b, g, sb_);
#define SATT_PV_STEP(T_, CUR) do { \
        stage_store(C, S, kind, true, CUR); \
        __syncthreads(); \
        if ((T_) + 2 < ntiles) stage_load(C, S, kind, (T_) + 2, true, b, g, CUR); \
        _Pragma("unroll 8") for (int k = 0; k < 64; ++k) { const float p = lg[(T_) * 64 + k]; a0 += p * Vt[k * 128 + C.lane]; a1 += p * Vt[k * 128 + 64 + C.lane]; } \
        __syncthreads(); } while (0)
    for (int t = 0; t < ntiles; t += 2) { SATT_PV_STEP(t, sa_); if (t + 1 < ntiles) SATT_PV_STEP(t + 1, sb_); }
#undef SATT_PV_STEP
    o0 += w * a0; o1 += w * a1;
}
DI void unit(const Ctx& C, const Src& S, int b, int g, const float* us, const float* qnorm, const float* gate_bias, const float* lutG, bf16_t* aos) {
    const int head = g * 8 + C.wave, lane = C.lane;
    LAS float* qs = (LAS float*)(C.lds + QS_OFF) + C.wave * 128;
    { const float q0 = us[b * 8448 + head * HD + lane], q1 = us[b * 8448 + head * HD + 64 + lane]; const float ss = wave_sum(q0 * q0 + q1 * q1);
      const float sc = frsq(ss * (1.f / HD) + EPS) * 0.08838834764831845f; qs[lane] = q0 * sc * qnorm[lane]; qs[64 + lane] = q1 * sc * qnorm[64 + lane]; }
    float bg[3];
#pragma unroll
    for (int k = 0; k < 3; ++k) bg[k] = sigmoidf_(us[b * 8448 + 8192 + head * 3 + k] + gate_bias[head * 3 + k]);
    __syncthreads();
    float o0 = 0.f, o1 = 0.f;
    logits_softmax(C, S, 0, 8, b, g, lutG);
    {
        LAS float* imp = (LAS float*)(C.lds + IMP_OFF); LAS int* sel = (LAS int*)(C.lds + SEL_OFF); LAS int* list = (LAS int*)(C.lds + LIST_OFF);
        if (C.tid < 129) { const int j = C.tid; float v = 0.f;
            for (int w = 0; w < 8; ++w) { LAS const float* pc = (LAS const float*)(C.lds + LG_OFF) + w * LG_STRIDE;
#pragma unroll
                for (int k = -1; k <= 3; ++k) { const int n = 4 * j + k; if (n >= 0 && n < 511) v += ((k == -1 || k == 3) ? 0.5f : 1.f) * pc[n]; } }
            imp[j] = v; }
        __syncthreads();
        if (C.tid < 129) { const int j = C.tid; int s_ = 0;
            if (j == 0 || j >= 127) s_ = 1;
            else { const float v = imp[j]; int rank = 0; for (int k = 1; k < 127; ++k) { const float vk = imp[k]; rank += (vk > v || (vk == v && k < j)) ? 1 : 0; } s_ = rank < 13; }
            sel[j] = s_; }
        __syncthreads();
        if (C.tid == 0) { int n = 0; for (int j = 0; j < 129 && n < 16; ++j) if (sel[j]) list[n++] = j; for (; n < 16; ++n) list[n] = 200; }
    }
    pv(C, S, 0, 8, b, g, bg[0], o0, o1);
    logits_softmax(C, S, 1, 16, b, g, lutG);
    pv(C, S, 1, 16, b, g, bg[1], o0, o1);
    logits_softmax(C, S, 2, 9, b, g, lutG);
    pv(C, S, 2, 9, b, g, bg[2], o0, o1);
    const float g0 = us[b * 8448 + DM + head * HD + lane], g1 = us[b * 8448 + DM + head * HD + 64 + lane];
    aos[b * DM + head * HD + lane] = (bf16_t)(cvt_pk_bf16(o0 * siluf_(g0), 0.f) & 0xffffu);
    aos[b * DM + head * HD + 64 + lane] = (bf16_t)(cvt_pk_bf16(o1 * siluf_(g1), 0.f) & 0xffffu);
    __syncthreads();
}
}

__global__ void __launch_bounds__(512, 2) fwd(Args args) {
    extern __shared__ __attribute__((aligned(16))) unsigned char lds_raw[];
    Ctx C; C.lds = (LAS unsigned char*)lds_raw; C.in = args.in; C.out = args.out; C.ws = args.ws; C.sm = (float*)(args.ws + WS_SMALL);
    C.tid = threadIdx.x; C.lane = C.tid & 63; C.wave = __builtin_amdgcn_readfirstlane(C.tid >> 6); C.G = gridDim.x;
    { const int bx = blockIdx.x; C.vcu = (C.G % 8 == 0) ? (bx % 8) * (C.G / 8) + bx / 8 : bx; }
    const int bid = blockIdx.x;
    volatile LAS unsigned* MISC = (volatile LAS unsigned*)(C.lds + LDS_MISC);
    if (C.tid < 64) MISC[C.tid] = 0u;
    if (C.lane == 0) ((volatile LAS int*)(C.lds + LDS_WTAB))[hw_wave_key()] = C.tid >> 6;
    __syncthreads();
    const int lo = args.ph_lo, hi = args.ph_hi;
    XcdBarrier bar; bar.bar = (unsigned*)(C.ws + WS_CTL) + CW_BAR; bar.x = 0; bar.st = MISC + 8;
    if (hi - lo > 1) bar = xcd_barrier_post((unsigned*)(C.ws + WS_CTL) + CW_BAR, MISC + 8);
#ifndef PMASK
#define PMASK 0xffffffffu
#endif
#define EN(b) ((PMASK >> (b)) & 1u)
#define IN(k) (lo <= (k) && (k) < hi)
#define SEAM(k) do { if (IN(k) && IN((k) + 1)) xcd_barrier(bar); } while (0)
    unsigned char* ws = C.ws; float* sm = C.sm; const float* rs = sm + SM_RS;
#define XB16 ((bf16_t*)(ws + WS_XB16))
#define XS16 ((bf16_t*)(sm + SM_XS16))
#define XA ((float*)(ws + WS_XA))
#define XBF ((float*)(ws + WS_XBF))
#define XSA (sm + SM_XS)
#define XSB (sm + SM_XS + 32768)

    if (IN(0) && EN(0)) { convert_tasks(reopaque(C), T_W1T, T_W1T + 8192, T_NORM, T_POSB, T_LUT, T_PAD); } SEAM(0);

#pragma unroll 1
    for (int L = 0; L < 2; ++L) {
        const int pb = 1 + 7 * L;
        { size_t z_ = 0; asm volatile("" : "+s"(z_)); ws += z_; sm = (float*)((unsigned char*)sm + z_); rs = (const float*)((const unsigned char*)rs + z_); }
        int bid = blockIdx.x; asm volatile("" : "+s"(bid));
        const float* xsin = L == 0 ? C.in[1] : XSA; float* xsout = L == 0 ? XSA : XSB;
        if (IN(pb + 0) && EN(1)) {
            pg8::Gemm g{XB16, (const bf16_t*)(ws + WS_W1T) + (size_t)L * 8192 * DM, DM, DM, DM, 0}; pg8::StaticOrder S; S.init(MP, 8192, C.G, bid);
            pg8::EpiBf16Rs E{(bf16_t*)(ws + WS_U), (bf16_t*)(ws + WS_U), 8192, rs, 1 << 20};
            const int slot = (bid & 7) >> 1;
            { pg8::RangeOrder R{S, 0, slot}; pg8::gemm_phase(C.lds, g, R, E); }
            if (L == 0) convert_tasks(reopaque(C), T_WGT, T_WGT + 512, T_W2T, T_W2T + 4096, T_W1T + 8192, T_W1T + 16384, T_POSB, T_LUT); else convert_tasks(reopaque(C), T_CACHE, T_NORM);
            { pg8::RangeOrder R{S, slot, 1 << 20}; pg8::gemm_phase(C.lds, g, R, E); }
            float* us = sm + SM_US; const float* rss = rs + MP;
            skinny_gemm(reopaque(C), XS16, DM, (const bf16_t*)(ws + WS_W1T) + (size_t)L * 8192 * DM, DM, 8192, DM, 0, [=](int row, int col, float v) { us[row * 8448 + col] = v * rss[row]; });
        } SEAM(pb + 0);
        if (IN(pb + 1) && EN(2)) {
            if (L == 0 && bid == 0) { float s_ = 0.f; int t_ = tid_now(C.lds); asm volatile("" : "+v"(t_));
                float pv_[16];
#pragma unroll
                for (int kc = 0; kc < 16; ++kc) pv_[kc] = sm[SM_POSBP + kc * 512 + t_];
                __builtin_amdgcn_sched_barrier(0);
#pragma unroll
                for (int kc = 0; kc < 16; ++kc) s_ += pv_[kc];
                sm[SM_POSB + t_] = s_; }
            conv_phase(reopaque(C), L); sample_conv(reopaque(C), L); } SEAM(pb + 1);
        if (IN(pb + 2) && EN(3)) {
            pg8::Gemm g{(const bf16_t*)(ws + WS_XC), (const bf16_t*)(ws + WS_WGT) + (size_t)L * 8192 * 256, DM, 256, 256, 1}; pg8::StaticOrder S; S.init(MP, 8192, C.G, bid);
            pg8::EpiGate E{(const bf16_t*)(ws + WS_XC), (bf16_t*)(ws + WS_LA), (bf16_t*)(ws + WS_BIN), C.in[13] + (size_t)L * DM, C.in[15] + (size_t)L * DM, sm + SM_SP8 + L * DM};
            pg8::gemm_phase(C.lds, g, S, E);
            float* gs = sm + SM_GS;
            skinny_gemm(reopaque(C), (const bf16_t*)(sm + SM_XCS16), DM, (const bf16_t*)(ws + WS_WGT) + (size_t)L * 8192 * 256, 256, 8192, 256, 1, [=](int row, int col, float v) { gs[row * 8192 + col] = v; });
        } SEAM(pb + 2);
        if (IN(pb + 3) && EN(4)) { scan_phase<1>(reopaque(C), L); sample_scan(reopaque(C), L); } SEAM(pb + 3);
        if (IN(pb + 4) && EN(5)) { scan_phase<3>(reopaque(C), L); } SEAM(pb + 4);
        if (IN(pb + 5) && EN(6)) {
            pg8::Gemm g{(const bf16_t*)(ws + WS_HG), (const bf16_t*)(ws + WS_W2T) + (size_t)L * DM * DM, DM, DM, DM, 0}; pg8::StaticOrder S; S.init(MP, DM, C.G, bid);
            pg8::EpiXRes<false> E{XB16, nullptr, (float*)(ws + WS_YB)};
            const bool cf = bid & 1;
            if (cf) { if (L == 0) convert_tasks(reopaque(C), T_WGT + 512, T_WGT + 1024, T_W2T + 4096, T_W2T + 8192, T_WKV, T_WIN, T_WC1, T_CACHE); else convert_tasks(reopaque(C), T_WIN, T_WIN + 8320, T_PAD, T_END); }
            pg8::gemm_phase(C.lds, g, S, E);
            if (!cf) { if (L == 0) convert_tasks(reopaque(C), T_WGT + 512, T_WGT + 1024, T_W2T + 4096, T_W2T + 8192, T_WKV, T_WIN, T_WC1, T_CACHE); else convert_tasks(reopaque(C), T_WIN, T_WIN + 8320, T_PAD, T_END); }
            skinny_gemm<1>(reopaque(C), (const bf16_t*)(sm + SM_HGS16), DM, (const bf16_t*)(ws + WS_W2T) + (size_t)L * DM * DM, DM, DM, DM, 0, [=](int row, int col, float v) { xsout[row * DM + col] = xsin[row * DM + col] + v; });
        } SEAM(pb + 5);
        if (IN(pb + 6) && EN(7)) { rs_phase(reopaque(C), (const float*)(ws + WS_YB), xsout); } SEAM(pb + 6);
    }

    if (IN(15) && EN(8)) {
        { pg8::Gemm g{XB16, (const bf16_t*)(ws + WS_WKVT), DM, DM, DM, 0}; pg8::StaticOrder S; S.init(MP, 3072, C.G, bid);
          pg8::EpiKV E{C.out + O_PCMP, C.out + O_PSLC, (float*)(ws + WS_WINRAW), rs};
          const bool cf = blockIdx.x & 1;
          if (cf) convert_tasks(reopaque(C), T_WOUT, T_WOUT + 4096);
          pg8::gemm_phase(C.lds, g, S, E);
          if (!cf) convert_tasks(reopaque(C), T_WOUT, T_WOUT + 4096); }
        { pg8::Gemm g{(const bf16_t*)(ws + WS_CMPS), (const bf16_t*)(ws + WS_WC1T), 2048, DM, DM, 0}; pg8::ListOrder S{128, C.G, (bid + C.G / 2) % C.G, 0, 0, 0};
          pg8::EpiHidS E{(bf16_t*)(ws + WS_HIDS), sm + SM_POSB};
          pg8::gemm_phase(C.lds, g, S, E); }
        float* kvs = sm + SM_KVS; const float* rss = rs + MP;
        skinny_gemm<1>(reopaque(C), XS16, DM, (const bf16_t*)(ws + WS_WKVT), DM, 3072, DM, 0, [=](int row, int col, float v) { kvs[row * 3072 + col] = v * rss[row]; });
    } SEAM(15);
    if (IN(16) && EN(9)) { kvpost_phase(reopaque(C)); } SEAM(16);

#pragma unroll 1
    for (int li = 0; li < 2; ++li) {
        { size_t z_ = 0; asm volatile("" : "+s"(z_)); ws += z_; sm = (float*)((unsigned char*)sm + z_); rs = (const float*)((const unsigned char*)rs + z_); }
        int bid = blockIdx.x; asm volatile("" : "+s"(bid));
        const int pb = li == 0 ? 17 : 22, p_att = li == 0 ? 19 : 23, p_out = li == 0 ? 20 : 24;
        const float* xsin = li == 0 ? XSB : XSA; float* xsout = li == 0 ? XSA : C.out + O_YS;
        const bf16_t* WIN = (const bf16_t*)(ws + WS_WINT) + (size_t)li * NINP * DM;
        if (IN(pb) && EN(10)) {
            { pg8::Gemm g{XB16, WIN, DM, DM, DM, 0}; pg8::StaticOrder S; S.init(MP, 8192, C.G, bid);
              pg8::EpiBf16Rs E{(bf16_t*)(ws + WS_U), (bf16_t*)(ws + WS_U) + (size_t)MP * DM, DM, rs, 16};
              const bool cf = bid & 1;
              if (cf && li == 0) convert_tasks(reopaque(C), T_WIN + 8320, T_WIN + 16640);
              pg8::gemm_phase(C.lds, g, S, E);
              if (!cf && li == 0) convert_tasks(reopaque(C), T_WIN + 8320, T_WIN + 16640); }
            { pg8::Gemm g{XB16, WIN, DM, DM, 512, 0}; pg8::ListOrder S{256, C.G, bid, 3, 7, 2};
              pg8::EpiPart E{(float*)(ws + WS_BIN), (size_t)MP * 128, 128, 1};
              pg8::gemm_phase(C.lds, g, S, E); }
            if (li == 0) { pg8::Gemm g{(const bf16_t*)(ws + WS_CMPP), (const bf16_t*)(ws + WS_WC1T), 2048, DM, 512, 0}; pg8::ListOrder S{128, C.G, bid, 3, 7, 1};
              pg8::EpiPart E{(float*)(ws + WS_LA), (size_t)4096 * 256, 256, 0};
              pg8::gemm_phase(C.lds, g, S, E); }
            float* us = sm + SM_US; const float* rss = rs + MP;
            skinny_gemm(reopaque(C), XS16, DM, WIN, DM, 8192, DM, 0, [=](int row, int col, float v) { us[row * 8448 + col] = v * rss[row]; });
            skinny_gemm<1>(reopaque(C), XS16, DM, WIN + (size_t)8192 * DM, DM, NIN - 8192, DM, 0, [=](int row, int col, float v) { us[row * 8448 + 8192 + col] = v * rss[row]; });
        } SEAM(pb);
        if (li == 0) { if (IN(18) && EN(11)) { cmp2_phase(reopaque(C)); } SEAM(18); }
        if (IN(p_att) && EN(12)) {
            att::Tensors T; T.UQ = (const bf16_t*)(ws + WS_U); T.SG = (const bf16_t*)(ws + WS_U) + (size_t)MP * DM; T.BGP = (const float*)(ws + WS_BIN); T.rs = rs;
            T.gate_bias = C.in[27] + li * 96; T.qnorm = C.in[28] + li * HD; T.knorm = C.in[20]; T.lutG = sm + SM_LUT;
            T.KCP = (const bf16_t*)(ws + WS_KCP); T.VCP = (const bf16_t*)(ws + WS_VCP); T.SLCK = (const bf16_t*)(ws + WS_SLCK); T.SLCV = (const bf16_t*)(ws + WS_SLCV);
            T.WINK = (const bf16_t*)(ws + WS_WINK); T.WINV = (const bf16_t*)(ws + WS_WINV); T.AO = (bf16_t*)(ws + WS_XC);
            satt::Src S; S.cslc = C.in[3]; S.swin = C.in[4]; S.ptab = (const int*)C.in[7]; S.kvs = sm + SM_KVS; S.kcs = (const bf16_t*)(ws + WS_KCS); S.vcs = (const bf16_t*)(ws + WS_VCS); S.knorm = C.in[20];
            unsigned* qctr = (unsigned*)(ws + WS_CTL) + CW_QUEUE + li * 64;
            if (tid_now(C.lds) == 0) MISC[16] = __hip_atomic_fetch_add(qctr, 1u, __ATOMIC_RELAXED, __HIP_MEMORY_SCOPE_AGENT);
            __syncthreads();
#pragma unroll 1
            for (;;) {
                const int idx = (int)MISC[16];
                if (idx >= 32 + 1024) break;
                if (idx < 32) { satt::unit(reopaque(C), S, idx >> 2, idx & 3, sm + SM_US, C.in[28] + li * HD, C.in[27] + li * 96, sm + SM_LUT, (bf16_t*)(sm + SM_AOS16));
                    if (tid_now(C.lds) == 0) MISC[16] = __hip_atomic_fetch_add(qctr, 1u, __ATOMIC_RELAXED, __HIP_MEMORY_SCOPE_AGENT);
                    __syncthreads(); }
                else { const int i = idx - 32, qt = 63 - (i >> 4), bg = i & 15; att::attn_unit(C.lds, T, bg >> 2, bg & 3, qt, qctr, MISC + 16); }
            }
        } SEAM(p_att);
        if (IN(p_out) && EN(13)) {
            pg8::Gemm g{(const bf16_t*)(ws + WS_XC), (const bf16_t*)(ws + WS_WOUTT) + (size_t)li * DM * DM, DM, DM, DM, 0}; pg8::StaticOrder S; S.init(MP, DM, C.G, bid);
            const bool cf = bid & 1;
            if (cf && li == 0) convert_tasks(reopaque(C), T_WOUT + 4096, T_WOUT + 8192);
            if (li == 0) { pg8::EpiXRes<false> E{XB16, nullptr, (float*)(ws + WS_YB)}; pg8::gemm_phase(C.lds, g, S, E); }
            else { pg8::EpiXRes<true> E{XB16, C.out + O_YP, nullptr, C.lds + 131072}; pg8::gemm_phase(C.lds, g, S, E); }
            if (!cf && li == 0) convert_tasks(reopaque(C), T_WOUT + 4096, T_WOUT + 8192);
            skinny_gemm<1>(reopaque(C), (const bf16_t*)(sm + SM_AOS16), DM, (const bf16_t*)(ws + WS_WOUTT) + (size_t)li * DM * DM, DM, DM, DM, 0, [=](int row, int col, float v) { xsout[row * DM + col] = xsin[row * DM + col] + v; });
        } SEAM(p_out);
        if (li == 0) { if (IN(21) && EN(14)) { rs_phase(reopaque(C), (const float*)(ws + WS_YB), xsout); } SEAM(21); }
    }
#undef IN
#undef SEAM
#undef XB16
#undef XS16
#undef XA
#undef XBF
#undef XSA
#undef XSB
}

#ifndef N_LAUNCH_MODE
#define N_LAUNCH_MODE 1
#endif
extern "C" void kernel_launch(void* const* d_in, const int* in_sizes, int n_in, void* d_out, int out_size, void* d_ws, size_t ws_size, hipStream_t stream) {
    static int grid = 0;
    if (grid == 0) {
        if (n_in != 30 || (size_t)out_size != O_END || ws_size < WS_END) { fprintf(stderr, "kernel_launch: unexpected shapes (n_in %d, out %d vs %zu, ws %zu vs %zu); nothing launched\n", n_in, out_size, (size_t)O_END, ws_size, (size_t)WS_END); grid = -1; return; }
        int dev = 0, cus = 0;
        if (hipGetDevice(&dev) != hipSuccess || hipDeviceGetAttribute(&cus, hipDeviceAttributeMultiprocessorCount, dev) != hipSuccess || cus <= 0) { fprintf(stderr, "kernel_launch: device query failed\n"); grid = -1; return; }
        if (hipFuncSetAttribute((const void*)fwd, hipFuncAttributeMaxDynamicSharedMemorySize, LDS_BYTES) != hipSuccess) { fprintf(stderr, "kernel_launch: hipFuncSetAttribute failed\n"); grid = -1; return; }
        int per_cu = 0;
        if (hipOccupancyMaxActiveBlocksPerMultiprocessor(&per_cu, (const void*)fwd, 512, LDS_BYTES) != hipSuccess || per_cu < 1) { fprintf(stderr, "kernel_launch: occupancy query says %d blocks per CU\n", per_cu); }
        (void)hipGetLastError();
        grid = cus;
    }
    if (grid < 0) return;
    (void)hipMemsetAsync((char*)d_ws + WS_CTL, 0, CTL_BYTES, stream);
    Args a{};
    for (int i = 0; i < 30; ++i) a.in[i] = (const float*)d_in[i];
    a.out = (float*)d_out; a.ws = (unsigned char*)d_ws;
#if N_LAUNCH_MODE == 1
    a.ph_lo = 0; a.ph_hi = NPHASE;
    hipLaunchKernelGGL(fwd, dim3(grid), dim3(512), LDS_BYTES, stream, a);
#else
#ifndef DUP_MASK
#define DUP_MASK 0u
#endif
    for (int ph = 0; ph < NPHASE; ++ph) { a.ph_lo = ph; a.ph_hi = ph + 1; hipLaunchKernelGGL(fwd, dim3(grid), dim3(512), LDS_BYTES, stream, a);
        if ((DUP_MASK >> ph) & 1u) hipLaunchKernelGGL(fwd, dim3(grid), dim3(512), LDS_BYTES, stream, a); }
#endif
}
```
